# Optimizing an MI355X kernel written in HIP

```python
import jax
import jax.numpy as jnp
from jax import lax
import numpy as np

D_MODEL = 2048
BATCH = 4
SEQ = 2048
DEPTH = 2

HEAD_DIM = 128
NSA_HEADS = D_MODEL // (2 * HEAD_DIM)
NSA_KV_HEADS = NSA_HEADS // 4
RET_HEADS = D_MODEL // (2 * HEAD_DIM)
NSA_W = NSA_HEADS * HEAD_DIM
NSA_KV_W = NSA_KV_HEADS * HEAD_DIM
RET_W = RET_HEADS * HEAD_DIM
CMP_BLOCK = 32
CMP_STRIDE = 16
SLC_BLOCK = 64
SLC_TOPK = 16
WINDOW = 512
NSA_Q_CHUNK = 64
WIN_Q_BLOCK = 128
RET_CHUNK = 128
N_MEM = 256
XA_HEADS = 4
XA_HEAD_DIM = D_MODEL // XA_HEADS
PEER_HEADS = 8
PEER_NKEYS = 128
PEER_N_EXPERTS = PEER_NKEYS * PEER_NKEYS
PEER_QUERY_DIM = 256
PEER_HALF = PEER_QUERY_DIM // 2
PEER_TOPK = 16
PEER_TOKEN_CHUNK = 128
ROPE_THETA = 10000.0
LN_EPS = 1e-5
GN_EPS = 1e-5
ALPHA = (2 * DEPTH) ** 0.25
BETA = (8 * DEPTH) ** -0.25
NEG_INF = -1e30
FORCE_SCORE = 1e9
IN_SIZES = (NSA_W, NSA_KV_W, NSA_KV_W, NSA_KV_W, NSA_KV_W, NSA_KV_W, NSA_KV_W, 3 * NSA_HEADS, RET_W, RET_W, RET_W, RET_W)
IN_COL_SCALE = (1.0, 1.0, BETA, 1.0, BETA, 1.0, BETA, 1.0, 1.0, 1.0, BETA, 1.0)
P_IN = sum(IN_SIZES)

kernel_name = 'hybrid_nsa_retention_peer_block'


def layer_norm(x, g, b):
    xf = x.astype(jnp.float32)
    mu = xf.mean(-1, keepdims=True)
    var = ((xf - mu) ** 2).mean(-1, keepdims=True)
    return ((xf - mu) * lax.rsqrt(var + LN_EPS) * g + b).astype(x.dtype)


def rope(x):
    S, Dh = x.shape[1], x.shape[-1]
    inv = 1.0 / (ROPE_THETA ** (jnp.arange(0, Dh, 2, dtype=jnp.float32) / Dh))
    ang = jnp.arange(S, dtype=jnp.float32)[:, None] * inv[None, :]
    cos = jnp.cos(ang)[:, None, :]
    sin = jnp.sin(ang)[:, None, :]
    xf = x.astype(jnp.float32)
    x1, x2 = xf[..., :Dh // 2], xf[..., Dh // 2:]
    return jnp.concatenate([x1 * cos - x2 * sin, x1 * sin + x2 * cos], -1).astype(x.dtype)


def nsa_attention(q, kc, vc, ks, vs, kw, vw, gate_logits, cmp_pos, cmp_w1, cmp_w2):
    B, S, H, Dh = q.shape
    Hkv = kc.shape[2]
    G = H // Hkv
    f32 = jnp.float32
    scale = Dh ** -0.5
    tpos = jnp.arange(S)

    n_cmp = (S - CMP_BLOCK) // CMP_STRIDE + 1
    blk_start = jnp.arange(n_cmp) * CMP_STRIDE
    gidx = blk_start[:, None] + jnp.arange(CMP_BLOCK)[None, :]

    def compress(t, i):
        tb = t[:, gidx] + cmp_pos[i][None, None, :, None, :]
        tb = tb.transpose(0, 1, 3, 2, 4).reshape(B, n_cmp, Hkv, CMP_BLOCK * Dh)
        return jax.nn.gelu(tb @ cmp_w1[i], approximate=False) @ cmp_w2[i]

    k_cmp = compress(kc, 0)
    v_cmp = compress(vc, 1)
    qg = q.reshape(B, S, Hkv, G, Dh)
    s_c = jnp.einsum('bsgrd,bngd->bgrsn', qg, k_cmp).astype(f32) * scale
    vis_c = (blk_start + CMP_BLOCK - 1)[None, :] <= tpos[:, None]
    p_c = jnp.where(vis_c, jax.nn.softmax(jnp.where(vis_c, s_c, NEG_INF), axis=-1), 0.0)
    o_c = jnp.einsum('bgrsn,bngd->bsgrd', p_c.astype(q.dtype), v_cmp).reshape(B, S, H, Dh)

    n_slc = S // SLC_BLOCK
    slc_start = jnp.arange(n_slc) * SLC_BLOCK
    overlap = ((blk_start[:, None] < (slc_start + SLC_BLOCK)[None, :]) &
               ((blk_start + CMP_BLOCK)[:, None] > slc_start[None, :])).astype(f32)
    imp = jnp.einsum('bgrsn,nj->bgsj', p_c, overlap)
    cur = tpos // SLC_BLOCK
    jb = jnp.arange(n_slc)
    forced = (jb[None, :] == 0) | (jb[None, :] == cur[:, None]) | (jb[None, :] == cur[:, None] - 1)
    score = jnp.where(forced, FORCE_SCORE, imp)
    score = jnp.where(slc_start[None, :] <= tpos[:, None], score, -1.0)
    n_top = min(SLC_TOPK, n_slc)
    _, sel = lax.top_k(score, n_top)

    q_r = rope(q)
    ks_r = rope(ks)
    kw_r = rope(kw)

    ks_blk = ks_r.reshape(B, n_slc, SLC_BLOCK, Hkv, Dh).transpose(0, 3, 1, 2, 4)
    vs_blk = vs.reshape(B, n_slc, SLC_BLOCK, Hkv, Dh).transpose(0, 3, 1, 2, 4)
    C = NSA_Q_CHUNK
    n_ch = S // C
    q_ch = q_r.reshape(B, n_ch, C, Hkv, G, Dh).transpose(1, 0, 3, 2, 4, 5)
    sel_ch = sel.reshape(B, Hkv, n_ch, C, n_top).transpose(2, 0, 1, 3, 4)
    pos_ch = tpos.reshape(n_ch, C)
    bi = jnp.arange(B)[:, None, None, None]
    gi = jnp.arange(Hkv)[None, :, None, None]

    def sel_chunk(args):
        qc, sc, pc = args
        kg = ks_blk[bi, gi, sc]
        vg = vs_blk[bi, gi, sc]
        kpos = sc[..., None] * SLC_BLOCK + jnp.arange(SLC_BLOCK)
        ok = (kpos <= pc[None, None, :, None, None])[:, :, :, None]
        s = jnp.einsum('bgcrd,bgcnld->bgcrnl', qc, kg).astype(f32) * scale
        s = jnp.where(ok, s, NEG_INF).reshape(B, Hkv, C, G, n_top * SLC_BLOCK)
        p = jax.nn.softmax(s, axis=-1).reshape(B, Hkv, C, G, n_top, SLC_BLOCK).astype(qc.dtype)
        return jnp.einsum('bgcrnl,bgcnld->bgcrd', p, vg)

    o_s = lax.map(sel_chunk, (q_ch, sel_ch, pos_ch))
    o_s = o_s.transpose(1, 0, 3, 2, 4, 5).reshape(B, S, H, Dh)

    WQ = WIN_Q_BLOCK
    n_qb = S // WQ
    span = WINDOW + WQ
    pad = ((0, 0), (WINDOW, 0), (0, 0), (0, 0))
    kw_pad = jnp.pad(kw_r, pad)
    vw_pad = jnp.pad(vw, pad)
    widx = jnp.arange(n_qb)[:, None] * WQ + jnp.arange(span)[None, :]
    kwin = kw_pad[:, widx]
    vwin = vw_pad[:, widx]
    kpos = widx - WINDOW
    qpos = tpos.reshape(n_qb, WQ)
    ok_w = ((kpos[:, None, :] <= qpos[:, :, None]) &
            (qpos[:, :, None] - kpos[:, None, :] < WINDOW) &
            (kpos[:, None, :] >= 0))
    qb = q_r.reshape(B, n_qb, WQ, Hkv, G, Dh)
    s_w = jnp.einsum('bqtgrd,bqkgd->bqgrtk', qb, kwin).astype(f32) * scale
    s_w = jnp.where(ok_w[None, :, None, None], s_w, NEG_INF)
    p_w = jax.nn.softmax(s_w, axis=-1).astype(q.dtype)
    o_w = jnp.einsum('bqgrtk,bqkgd->bqtgrd', p_w, vwin).reshape(B, S, H, Dh)

    g = jax.nn.sigmoid(gate_logits.astype(f32)).astype(q.dtype)
    return g[..., 0:1] * o_c + g[..., 1:2] * o_s + g[..., 2:3] * o_w


def retention(q, k, v, gate, gn_g, gn_b):
    B, S, H, Dh = q.shape
    f32 = jnp.float32
    q = rope(q).astype(f32)
    k = rope(k).astype(f32) * (Dh ** -0.5)
    v = v.astype(f32)
    log_g = jnp.log(1.0 - 2.0 ** (-5.0 - jnp.arange(H, dtype=f32)))
    C = RET_CHUNK
    n = S // C
    i = jnp.arange(C, dtype=f32)
    diff = i[:, None] - i[None, :]
    causal = diff >= 0
    dmask = jnp.where(causal[None], jnp.exp(jnp.where(causal, diff, 0.0)[None] * log_g[:, None, None]), 0.0)
    xi = jnp.exp((i[None, :] + 1.0) * log_g[:, None])
    zeta = jnp.exp((C - 1.0 - i[None, :]) * log_g[:, None])
    cdec = jnp.exp(C * log_g)

    def to_ch(t):
        return t.reshape(B, n, C, H, t.shape[-1]).transpose(1, 0, 3, 2, 4)

    def step(R, inp):
        qi, ki, vi = inp
        inner = jnp.einsum('bhid,bhjd->bhij', qi, ki) * dmask
        o = jnp.einsum('bhij,bhjv->bhiv', inner, vi) + jnp.einsum('bhid,bhdv->bhiv', qi, R) * xi[None, :, :, None]
        R = R * cdec[None, :, None, None] + jnp.einsum('bhjd,bhjv->bhdv', ki * zeta[None, :, :, None], vi)
        return R, o

    R0 = jnp.zeros((B, H, Dh, v.shape[-1]), f32)
    _, ys = lax.scan(step, R0, (to_ch(q), to_ch(k), to_ch(v)))
    y = ys.transpose(1, 0, 3, 2, 4).reshape(B, S, H, -1)
    mu = y.mean(-1, keepdims=True)
    var = ((y - mu) ** 2).mean(-1, keepdims=True)
    y = ((y - mu) * lax.rsqrt(var + GN_EPS)).reshape(B, S, -1) * gn_g + gn_b
    return (jax.nn.silu(gate.astype(f32)) * y).astype(gate.dtype)


def hybrid_mixer(x, w_in, b_gate, cmp_pos, cmp_w1, cmp_w2, gn_g, gn_b, w_out):
    B, S, _ = x.shape
    proj = x @ w_in
    offs = np.cumsum(IN_SIZES)[:-1].tolist()
    (q, kc, vc, ks, vs, kw, vw, gl, rq, rk, rv, rg) = jnp.split(proj, offs, axis=-1)

    def heads(t, h):
        return t.reshape(B, S, h, HEAD_DIM)

    o_nsa = nsa_attention(heads(q, NSA_HEADS), heads(kc, NSA_KV_HEADS), heads(vc, NSA_KV_HEADS),
                          heads(ks, NSA_KV_HEADS), heads(vs, NSA_KV_HEADS),
                          heads(kw, NSA_KV_HEADS), heads(vw, NSA_KV_HEADS),
                          (gl + b_gate).reshape(B, S, NSA_HEADS, 3), cmp_pos, cmp_w1, cmp_w2)
    o_ret = retention(heads(rq, RET_HEADS), heads(rk, RET_HEADS), heads(rv, RET_HEADS), rg, gn_g, gn_b)
    return jnp.concatenate([o_nsa.reshape(B, S, NSA_W), o_ret], axis=-1) @ w_out


def memory_cross_attention(x, mem, wq, wk, wv, wo):
    B, S, D = x.shape
    M = mem.shape[1]
    q = (x @ wq).reshape(B, S, XA_HEADS, XA_HEAD_DIM)
    k = (mem @ wk).reshape(B, M, XA_HEADS, XA_HEAD_DIM)
    v = (mem @ wv).reshape(B, M, XA_HEADS, XA_HEAD_DIM)
    s = jnp.einsum('bshd,bmhd->bhsm', q, k).astype(jnp.float32) * (XA_HEAD_DIM ** -0.5)
    p = jax.nn.softmax(s, axis=-1).astype(x.dtype)
    o = jnp.einsum('bhsm,bmhd->bshd', p, v).reshape(B, S, D)
    return o @ wo


def peer_ffn(x, w_q, sub_keys, u_tab, v_tab):
    B, S, D = x.shape
    T = B * S
    xt = x.reshape(T, D)
    q = (xt @ w_q).reshape(T, PEER_HEADS, 2, PEER_HALF)
    s = jnp.einsum('thpk,hpnk->thpn', q, sub_keys).astype(jnp.float32)
    s1, i1 = lax.top_k(s[:, :, 0], PEER_TOPK)
    s2, i2 = lax.top_k(s[:, :, 1], PEER_TOPK)
    cand = (s1[..., :, None] + s2[..., None, :]).reshape(T, PEER_HEADS, PEER_TOPK * PEER_TOPK)
    top, pos = lax.top_k(cand, PEER_TOPK)
    e = (jnp.take_along_axis(i1, pos // PEER_TOPK, axis=-1) * PEER_NKEYS +
         jnp.take_along_axis(i2, pos % PEER_TOPK, axis=-1))
    g = jax.nn.softmax(top, axis=-1).astype(x.dtype)
    C = PEER_TOKEN_CHUNK
    n_ch = T // C

    def chunk(args):
        xc, ec, gc = args
        h = jax.nn.gelu(jnp.einsum('td,thkd->thk', xc, u_tab[ec]), approximate=False)
        return jnp.einsum('thk,thkd->td', gc * h, v_tab[ec])

    out = lax.map(chunk, (xt.reshape(n_ch, C, D), e.reshape(n_ch, C, PEER_HEADS, PEER_TOPK),
                          g.reshape(n_ch, C, PEER_HEADS, PEER_TOPK)))
    return out.reshape(B, S, D)


def setup_inputs(seed: int = 0) -> dict:
    key = jax.random.key(seed)
    k = jax.random.split(key, 24)
    L, D, f32 = DEPTH, D_MODEL, jnp.float32

    def nrm(kk, shape, scale):
        return jax.random.normal(kk, shape, f32) * scale

    col_scale = jnp.concatenate([jnp.full((n,), s, f32) for n, s in zip(IN_SIZES, IN_COL_SCALE)])
    return {
        'x': nrm(k[0], (BATCH, SEQ, D), 1.0),
        'mem': nrm(k[1], (BATCH, N_MEM, D), 1.0),
        'w_in': nrm(k[2], (L, D, P_IN), D ** -0.5) * col_scale,
        'b_gate': nrm(k[3], (L, 3 * NSA_HEADS), 0.01),
        'cmp_pos': nrm(k[4], (L, 2, CMP_BLOCK, HEAD_DIM), 0.02),
        'cmp_w1': nrm(k[5], (L, 2, CMP_BLOCK * HEAD_DIM, HEAD_DIM), (CMP_BLOCK * HEAD_DIM) ** -0.5),
        'cmp_w2': nrm(k[6], (L, 2, HEAD_DIM, HEAD_DIM), HEAD_DIM ** -0.5),
        'ret_gn_g': 1.0 + nrm(k[7], (L, RET_W), 0.02),
        'ret_gn_b': nrm(k[8], (L, RET_W), 0.02),
        'w_mix_out': nrm(k[9], (L, D, D), BETA * D ** -0.5),
        'ln1_g': 1.0 + nrm(k[10], (L, D), 0.02),
        'ln1_b': nrm(k[11], (L, D), 0.02),
        'xa_wq': nrm(k[12], (L, D, D), D ** -0.5),
        'xa_wk': nrm(k[13], (L, D, D), D ** -0.5),
        'xa_wv': nrm(k[14], (L, D, D), BETA * D ** -0.5),
        'xa_wo': nrm(k[15], (L, D, D), BETA * D ** -0.5),
        'ln2_g': 1.0 + nrm(k[16], (L, D), 0.02),
        'ln2_b': nrm(k[17], (L, D), 0.02),
        'peer_wq': nrm(k[18], (L, D, PEER_HEADS * PEER_QUERY_DIM), D ** -0.5),
        'peer_sub_keys': nrm(k[19], (L, PEER_HEADS, 2, PEER_NKEYS, PEER_HALF), PEER_HALF ** -0.5),
        'peer_u': nrm(k[20], (L, PEER_N_EXPERTS, D), D ** -0.5),
        'peer_v': nrm(k[21], (L, PEER_N_EXPERTS, D), BETA * PEER_HEADS ** -0.5),
        'ln3_g': 1.0 + nrm(k[22], (L, D), 0.02),
        'ln3_b': nrm(k[23], (L, D), 0.02),
    }


def reference(x, mem, w_in, b_gate, cmp_pos, cmp_w1, cmp_w2, ret_gn_g, ret_gn_b, w_mix_out,
              ln1_g, ln1_b, xa_wq, xa_wk, xa_wv, xa_wo, ln2_g, ln2_b,
              peer_wq, peer_sub_keys, peer_u, peer_v, ln3_g, ln3_b):
    for l in range(DEPTH):
        h = hybrid_mixer(x, w_in[l], b_gate[l], cmp_pos[l], cmp_w1[l], cmp_w2[l],
                         ret_gn_g[l], ret_gn_b[l], w_mix_out[l])
        x = layer_norm(ALPHA * x + h, ln1_g[l], ln1_b[l])
        h = memory_cross_attention(x, mem, xa_wq[l], xa_wk[l], xa_wv[l], xa_wo[l])
        x = layer_norm(ALPHA * x + h, ln2_g[l], ln2_b[l])
        h = peer_ffn(x, peer_wq[l], peer_sub_keys[l], peer_u[l], peer_v[l])
        x = layer_norm(ALPHA * x + h, ln3_g[l], ln3_b[l])
    return x
```

```cpp
#include <hip/hip_runtime.h>
#include <hip/hip_cooperative_groups.h>
#include <cstdio>
namespace cg = cooperative_groups;
#ifndef TOPK_REP
#define TOPK_REP 1
#endif

#define DI __device__ __forceinline__
typedef unsigned short u16;
using bf16x8 = __attribute__((ext_vector_type(8))) short;
using f32x16 = __attribute__((ext_vector_type(16))) float;
using u32x4 = __attribute__((ext_vector_type(4))) unsigned;
using u32x2 = __attribute__((ext_vector_type(2))) unsigned;
using u32x6 = __attribute__((ext_vector_type(6))) unsigned;
using f32x16v = __attribute__((ext_vector_type(16))) float;
using f32x32 = __attribute__((ext_vector_type(32))) float;
#define MFMA(a, b, c) __builtin_amdgcn_mfma_f32_32x32x16_bf16((a), (b), (c), 0, 0, 0)

static constexpr int T = 8192, D = 2048, S = 2048, NB = 4, PIN = 6680;
static constexpr float ALPHA = 1.4142135623730951f;
static constexpr float SC128 = 0.08838834764831845f;
static constexpr float SC512 = 0.04419417382415922f;
static constexpr float NEG = -1e30f;

enum { I_X = 0, I_MEM, I_WIN, I_BGATE, I_CPOS, I_CW1, I_CW2, I_GNG, I_GNB, I_WOUT, I_LN1G, I_LN1B, I_XWQ, I_XWK, I_XWV, I_XWO,
       I_LN2G, I_LN2B, I_PWQ, I_PSK, I_PU, I_PV, I_LN3G, I_LN3B };

static constexpr size_t MB = 1ull << 20;
static constexpr size_t WS_XB = 0;
static constexpr size_t WS_XF = WS_XB + 32 * MB;
static constexpr size_t WS_Y = WS_XF + 64 * MB;
static constexpr size_t WS_MEMB = WS_Y + 64 * MB;
static constexpr size_t WS_ROPE = WS_MEMB + 4 * MB;
static constexpr size_t WS_QN = WS_ROPE + 1 * MB;
static constexpr size_t WS_QR = WS_QN + 16 * MB;
static constexpr size_t WS_KC = WS_QR + 16 * MB;
static constexpr size_t WS_VC = WS_KC + 4 * MB;
static constexpr size_t WS_KS = WS_VC + 4 * MB;
static constexpr size_t WS_VST = WS_KS + 4 * MB;
static constexpr size_t WS_KW = WS_VST + 4 * MB;
static constexpr size_t WS_VWT = WS_KW + 4 * MB;
static constexpr size_t WS_GATES = WS_VWT + 4 * MB;
static constexpr size_t WS_RQ = WS_GATES + 1 * MB;
static constexpr size_t WS_RK = WS_RQ + 16 * MB;
static constexpr size_t WS_RKZT = WS_RK + 16 * MB;
static constexpr size_t WS_RVT = WS_RKZT + 16 * MB;
static constexpr size_t WS_RGS = WS_RVT + 16 * MB;
static constexpr size_t WS_XK = WS_RGS + 16 * MB;
static constexpr size_t WS_XVT = WS_XK + 4 * MB;
static constexpr size_t WS_CPART = WS_XVT + 4 * MB;
static constexpr size_t WS_KCMP = WS_CPART + 8 * MB;
static constexpr size_t WS_VCMPT = WS_KCMP + 1 * MB;
static constexpr size_t WS_POSB = WS_VCMPT + 1 * MB;
static constexpr size_t WS_WT = WS_POSB + 1 * MB;
static constexpr size_t WS_SST = WS_WT + 162 * MB;
static constexpr size_t WS_ONSA = WS_SST + 32 * MB;
static constexpr size_t WS_MIX = WS_ONSA + 32 * MB;
static constexpr size_t WS_SEL = WS_MIX + 32 * MB;
static constexpr size_t WS_XQ = WS_SEL + 1 * MB;
static constexpr size_t WS_XO = WS_XQ + 32 * MB;
static constexpr size_t WS_SCORES = WS_XO + 32 * MB;
static constexpr size_t WS_UB = WS_SCORES + 64 * MB;
static constexpr size_t WS_VB = WS_UB + 64 * MB;
static constexpr size_t WS_RBUF = WS_VB + 64 * MB;
static constexpr size_t WS_OC = WS_RBUF + 16 * MB;
static constexpr size_t WS_BAR = WS_OC + 32 * MB;
static constexpr size_t WS_END = WS_BAR + 1 * MB;

static constexpr size_t WT_IN = 0;
static constexpr size_t WT_OUT = (size_t)6784 * 2048;
static constexpr size_t WT_XQ = WT_OUT + (size_t)2048 * 2048;
static constexpr size_t WT_XK = WT_XQ + (size_t)2048 * 2048;
static constexpr size_t WT_XV = WT_XK + (size_t)2048 * 2048;
static constexpr size_t WT_XO = WT_XV + (size_t)2048 * 2048;
static constexpr size_t WT_WP = WT_XO + (size_t)2048 * 2048;
static constexpr size_t WT_CW1 = WT_WP + (size_t)2048 * 2048;
static constexpr size_t WT_LAYER = WT_CW1 + (size_t)2 * 128 * 4096;
static_assert(2 * WT_LAYER * 2 <= 162 * MB, "WT region");

struct P {
    const float* in[24];
    float* out;
    char* ws;
};

typedef float f32x2_t __attribute__((ext_vector_type(2)));
typedef __bf16 bf16x2_t __attribute__((ext_vector_type(2)));
DI unsigned pk2(float a, float b) { f32x2_t v = {a, b}; return __builtin_bit_cast(unsigned, __builtin_convertvector(v, bf16x2_t)); }
DI u16 f2bf(float x) { return (u16)(pk2(x, x) & 0xffffu); }
DI float bflo(unsigned v) { return __uint_as_float(v << 16); }
DI float bfhi(unsigned v) { return __uint_as_float(v & 0xffff0000u); }
DI const float* lnd(const float* q) { size_t o = 0; asm volatile("" : "+s"(o)); return q + o; }
DI int TID() { int t = threadIdx.x; asm volatile("" : "+v"(t)); return t; }
DI int BID() { int t = blockIdx.x; asm volatile("" : "+s"(t)); return t; }
DI int GDIM() { int t = gridDim.x; asm volatile("" : "+s"(t)); return t; }
DI int crow(int i, int h) { return (i & 3) + 8 * (i >> 2) + 4 * h; }
DI bf16x8 ldfrag(const u16* p) { return *(const bf16x8*)p; }
DI bf16x8 ld2x8(const u16* p0, const u16* p1) {
    u32x2 a = *(const u32x2*)p0; u32x2 b = *(const u32x2*)p1; u32x4 v = {a[0], a[1], b[0], b[1]};
    return __builtin_bit_cast(bf16x8, v);
}
DI bf16x8 pack8(float a0, float a1, float a2, float a3, float a4, float a5, float a6, float a7) {
    u32x4 v = {pk2(a0, a1), pk2(a2, a3), pk2(a4, a5), pk2(a6, a7)};
    return __builtin_bit_cast(bf16x8, v);
}
DI f32x16 zero16() { f32x16 z; for (int i = 0; i < 16; ++i) z[i] = 0.f; return z; }
DI float gelu_erf(float x) { return 0.5f * x * (1.f + erff(x * 0.7071067811865476f)); }
DI float wave_sum(float v) { for (int o = 32; o >= 1; o >>= 1) v += __shfl_xor(v, o); return v; }
#define CBAR() __asm__ volatile("" ::: "memory")

enum { E_QDUAL = 0, E_PLAIN, E_ROPE, E_VT, E_RK, E_GATE, E_SILU, E_XVT, E_RESID, E_F32 };
struct GT {
    const u16* A; int lda; int amode; int M; int m0; int kbeg;
    const u16* B; int ldb; int ncols; int K;
    int emode; int e0; int e1;
    void* dst; const float* aux;
};

DI void gemm_tile(const P& p, int L, char* smem, const GT& g) {
    u16* As = (u16*)smem;
    u16* Bs = (u16*)(smem + 36864);
    const int tid = TID(), lane = tid & 63, w = tid >> 6, r = lane & 31, h = lane >> 5;
    const int trow = tid >> 3, tkc = tid & 7;
    unsigned voffa, voffb;
    size_t astep;
    const u16* abase;
    if (g.amode == 0) { voffa = (unsigned)(trow * g.lda + tkc * 8) * 2u; astep = (size_t)32 * g.lda; abase = g.A + (size_t)g.m0 * g.lda; }
    else { voffa = (unsigned)((trow >> 1) * 4096 + (trow & 1) * 128 + tkc * 8) * 2u; astep = 65536; abase = g.A + (size_t)(g.m0 >> 8) * 2048 * 256; }
    voffb = (unsigned)(trow * g.ldb + tkc * 8) * 2u;
    const size_t bstep = (size_t)32 * g.ldb;
    const int brows = (g.ncols + 31) >> 5;
    f32x16 acc[2][4];
#pragma unroll
    for (int a = 0; a < 2; ++a)
#pragma unroll
        for (int b = 0; b < 4; ++b) acc[a][b] = zero16();
    u32x4 pa[8], pb[4];
#define GLOAD(k0_) do { const int k0 = (k0_); const int koff = g.amode ? (((k0 + g.kbeg) >> 7) * 256 + ((k0 + g.kbeg) & 127)) : k0; \
        _Pragma("unroll") for (int i = 0; i < 8; ++i) pa[i] = *(const u32x4*)((const char*)(abase + (size_t)i * astep + koff) + voffa); \
        _Pragma("unroll") for (int i = 0; i < 4; ++i) pb[i] = *(const u32x4*)((const char*)(g.B + (size_t)(i < brows ? i : 0) * bstep + k0) + voffb); } while (0)
#define SSTORE() do { \
        _Pragma("unroll") for (int i = 0; i < 8; ++i) *(u32x4*)&As[((tid >> 3) + 32 * i) * 72 + (tid & 7) * 8] = pa[i]; \
        _Pragma("unroll") for (int i = 0; i < 4; ++i) *(u32x4*)&Bs[((tid >> 3) + 32 * i) * 72 + (tid & 7) * 8] = pb[i]; } while (0)
#define RDA(ks_) do { fa[ks_][0] = *(const bf16x8*)(arp + (ks_) * 16); fa[ks_][1] = *(const bf16x8*)(arp + 32 * 72 + (ks_) * 16); } while (0)
#define RDB(ks_, nb_) fb[ks_][nb_] = *(const bf16x8*)(brp + (nb_) * 32 * 72 + (ks_) * 16)
#define MM(ks_, nb_) do { acc[0][nb_] = MFMA(fa[ks_][0], fb[ks_][nb_], acc[0][nb_]); acc[1][nb_] = MFMA(fa[ks_][1], fb[ks_][nb_], acc[1][nb_]); } while (0)
#define SB() __builtin_amdgcn_sched_barrier(0)
#define COMPUTE() do { bf16x8 fa[4][2], fb[4][4]; const u16* arp = &As[(w * 64 + r) * 72 + h * 8]; const u16* brp = &Bs[r * 72 + h * 8]; \
        RDA(0); RDB(0, 0); RDB(0, 1); SB(); \
        RDB(0, 2); SB(); MM(0, 0); SB(); \
        RDB(0, 3); SB(); MM(0, 1); SB(); \
        RDA(1); RDB(1, 0); SB(); MM(0, 2); SB(); \
        RDB(1, 1); SB(); MM(0, 3); SB(); \
        RDB(1, 2); SB(); MM(1, 0); SB(); \
        RDB(1, 3); SB(); MM(1, 1); SB(); \
        RDA(2); RDB(2, 0); SB(); MM(1, 2); SB(); \
        RDB(2, 1); SB(); MM(1, 3); SB(); \
        RDB(2, 2); SB(); MM(2, 0); SB(); \
        RDB(2, 3); SB(); MM(2, 1); SB(); \
        RDA(3); RDB(3, 0); SB(); MM(2, 2); SB(); \
        RDB(3, 1); SB(); MM(2, 3); SB(); \
        RDB(3, 2); SB(); MM(3, 0); SB(); \
        RDB(3, 3); SB(); MM(3, 1); SB(); \
        SB(); MM(3, 2); SB(); \
        SB(); MM(3, 3); SB(); } while (0)
    const int nk = g.K >> 6;
    GLOAD(0);
    __syncthreads();
    SSTORE();
    __syncthreads();
#pragma unroll 1
    for (int kt = 0; kt < nk; ++kt) {
        if (kt + 1 < nk) GLOAD((kt + 1) << 6);
        COMPUTE();
        __syncthreads();
        if (kt + 1 < nk) { SSTORE(); __syncthreads(); }
    }
#undef GLOAD
#undef SSTORE
#undef COMPUTE
#undef RDA
#undef RDB
#undef MM
#undef SB
    size_t wsoff_ = 0; asm volatile("" : "+s"(wsoff_)); char* ws = p.ws + wsoff_;
    const int rbase = g.m0 + w * 64;
    switch (g.emode) {
    case E_QDUAL: case E_ROPE: case E_RK: {
        const float2* tab = (const float2*)(ws + WS_ROPE);
        const float sc = (g.emode == E_RK) ? SC128 : 1.f;
        u16* dst = (u16*)g.dst;
        const int ld = g.e0, co = g.e1;
        float log2g = 0.f;
        if (g.emode == E_RK) log2g = log2f(1.f - exp2f(-5.f - (float)(co >> 7)));
        u16* dT = (u16*)(ws + WS_RKZT); const int head = co >> 7;
        u16* qn = (u16*)(ws + WS_QN);
#pragma unroll
        for (int mb = 0; mb < 2; ++mb)
#pragma unroll
            for (int a = 0; a < 4; ++a) {
                const int row0 = rbase + mb * 32 + 8 * a + 4 * h; const int b = row0 >> 11, s0 = row0 & 2047;
                float z[4] = {1.f, 1.f, 1.f, 1.f};
                if (g.emode == E_RK) {
#pragma unroll
                    for (int c = 0; c < 4; ++c) z[c] = exp2f((float)(127 - ((s0 + c) & 127)) * log2g);
                }
#pragma unroll
                for (int nb = 0; nb < 2; ++nb) {
                    const int d = nb * 32 + r;
                    float o1[4], o2[4];
#pragma unroll
                    for (int c = 0; c < 4; ++c) {
                        const int i = 4 * a + c; const int row = row0 + c;
                        float2 cs = tab[(s0 + c) * 64 + d];
                        float x1 = acc[mb][nb][i], x2 = acc[mb][nb + 2][i];
                        o1[c] = (x1 * cs.x - x2 * cs.y) * sc; o2[c] = (x1 * cs.y + x2 * cs.x) * sc;
                        if (g.emode == E_QDUAL) { qn[(size_t)row * ld + co + d] = f2bf(x1); qn[(size_t)row * ld + co + d + 64] = f2bf(x2); }
                        dst[(size_t)row * ld + co + d] = f2bf(o1[c]); dst[(size_t)row * ld + co + d + 64] = f2bf(o2[c]);
                    }
                    if (g.emode == E_RK) {
                        u32x2 v; v[0] = pk2(o1[0] * z[0], o1[1] * z[1]); v[1] = pk2(o1[2] * z[2], o1[3] * z[3]);
                        *(u32x2*)&dT[((size_t)(b * 8 + head) * 128 + d) * 2048 + s0] = v;
                        v[0] = pk2(o2[0] * z[0], o2[1] * z[1]); v[1] = pk2(o2[2] * z[2], o2[3] * z[3]);
                        *(u32x2*)&dT[((size_t)(b * 8 + head) * 128 + d + 64) * 2048 + s0] = v;
                    }
                }
                __builtin_amdgcn_sched_barrier(0);
            }
    } break;
    case E_PLAIN: case E_SILU: {
        u16* dst = (u16*)g.dst; const int ld = g.e0, co = g.e1;
#pragma unroll
        for (int mb = 0; mb < 2; ++mb)
#pragma unroll
            for (int i = 0; i < 16; ++i) {
                const int row = rbase + mb * 32 + crow(i, h);
                if (row < g.M) {
#pragma unroll
                    for (int nb = 0; nb < 4; ++nb) {
                        float v = acc[mb][nb][i];
                        if (g.emode == E_SILU) v = v / (1.f + __expf(-v));
                        dst[(size_t)row * ld + co + nb * 32 + r] = f2bf(v);
                    }
                }
            }
    } break;
    case E_VT: {
        u16* dT = (u16*)g.dst; const int nh = g.e0, head = g.e1;
#pragma unroll
        for (int mb = 0; mb < 2; ++mb)
#pragma unroll
            for (int a = 0; a < 4; ++a) {
                const int row0 = rbase + mb * 32 + 8 * a + 4 * h; const int b = row0 >> 11, s0 = row0 & 2047;
#pragma unroll
                for (int nb = 0; nb < 4; ++nb) {
                    const int d = nb * 32 + r;
                    u32x2 v; v[0] = pk2(acc[mb][nb][4 * a], acc[mb][nb][4 * a + 1]); v[1] = pk2(acc[mb][nb][4 * a + 2], acc[mb][nb][4 * a + 3]);
                    *(u32x2*)&dT[((size_t)(b * nh + head) * 128 + d) * 2048 + s0] = v;
                }
            }
    } break;
    case E_XVT: {
        u16* dT = (u16*)g.dst; const int head = g.e1 >> 9, d0 = g.e1 & 511;
#pragma unroll
        for (int mb = 0; mb < 2; ++mb)
#pragma unroll
            for (int a = 0; a < 4; ++a) {
                const int row0 = rbase + mb * 32 + 8 * a + 4 * h; const int b = row0 >> 8, m = row0 & 255;
#pragma unroll
                for (int nb = 0; nb < 4; ++nb) {
                    const int d = d0 + nb * 32 + r;
                    u32x2 v; v[0] = pk2(acc[mb][nb][4 * a], acc[mb][nb][4 * a + 1]); v[1] = pk2(acc[mb][nb][4 * a + 2], acc[mb][nb][4 * a + 3]);
                    *(u32x2*)&dT[((size_t)(b * 4 + head) * 512 + d) * 256 + m] = v;
                }
            }
    } break;
    case E_GATE: {
        float* dst = (float*)(ws + WS_GATES); const float* bg = lnd(p.in[I_BGATE]) + L * 24;
        if (r < 24) {
            const float bias = bg[r];
#pragma unroll
            for (int mb = 0; mb < 2; ++mb)
#pragma unroll
                for (int i = 0; i < 16; ++i) {
                    const int row = rbase + mb * 32 + crow(i, h);
                    float v = acc[mb][0][i] + bias;
                    dst[(size_t)row * 24 + r] = 1.f / (1.f + __expf(-v));
                }
        }
    } break;
    case E_RESID: {
        float* y = (float*)(ws + WS_Y); const float* xr = g.aux; const int co = g.e1;
#pragma unroll
        for (int mb = 0; mb < 2; ++mb)
#pragma unroll
            for (int i = 0; i < 16; ++i) {
                const int row = rbase + mb * 32 + crow(i, h);
#pragma unroll
                for (int nb = 0; nb < 4; ++nb) { size_t ix = (size_t)row * 2048 + co + nb * 32 + r; y[ix] = ALPHA * xr[ix] + acc[mb][nb][i]; }
            }
    } break;
    case E_F32: {
        float* dst = (float*)g.dst; const int ld = g.e0, co = g.e1;
#pragma unroll
        for (int mb = 0; mb < 2; ++mb)
#pragma unroll
            for (int i = 0; i < 16; ++i) {
                const int row = rbase + mb * 32 + crow(i, h);
#pragma unroll
                for (int nb = 0; nb < 4; ++nb) dst[(size_t)row * ld + co + nb * 32 + r] = acc[mb][nb][i];
            }
    } break;
    }
}

DI void inproj_desc(const P& p, int L, int nt, int mt, GT& g) {
    size_t wsoff_ = 0; asm volatile("" : "+s"(wsoff_)); char* ws = p.ws + wsoff_;
    g.A = (const u16*)(ws + WS_XB); g.lda = 2048; g.amode = 0; g.kbeg = 0; g.M = T; g.m0 = mt * 256; g.ldb = 2048; g.K = 2048; g.ncols = 128; g.aux = nullptr;
    const u16* W = (const u16*)(ws + WS_WT) + (size_t)L * WT_LAYER + WT_IN;
    int col0;
    if (nt < 8) { col0 = nt * 128; g.emode = E_QDUAL; g.dst = ws + WS_QR; g.e0 = 1024; g.e1 = nt * 128; }
    else if (nt < 10) { int q = nt - 8; col0 = 1024 + q * 128; g.emode = E_PLAIN; g.dst = ws + WS_KC; g.e0 = 256; g.e1 = q * 128; }
    else if (nt < 12) { int q = nt - 10; col0 = 1280 + q * 128; g.emode = E_PLAIN; g.dst = ws + WS_VC; g.e0 = 256; g.e1 = q * 128; }
    else if (nt < 14) { int q = nt - 12; col0 = 1536 + q * 128; g.emode = E_ROPE; g.dst = ws + WS_KS; g.e0 = 256; g.e1 = q * 128; }
    else if (nt < 16) { int q = nt - 14; col0 = 1792 + q * 128; g.emode = E_VT; g.dst = ws + WS_VST; g.e0 = 2; g.e1 = q; }
    else if (nt < 18) { int q = nt - 16; col0 = 2048 + q * 128; g.emode = E_ROPE; g.dst = ws + WS_KW; g.e0 = 256; g.e1 = q * 128; }
    else if (nt < 20) { int q = nt - 18; col0 = 2304 + q * 128; g.emode = E_VT; g.dst = ws + WS_VWT; g.e0 = 2; g.e1 = q; }
    else if (nt == 20) { col0 = 2560; g.emode = E_GATE; g.ncols = 24; g.dst = nullptr; g.e0 = 0; g.e1 = 0; }
    else if (nt < 29) { int q = nt - 21; col0 = 2584 + q * 128; g.emode = E_ROPE; g.dst = ws + WS_RQ; g.e0 = 1024; g.e1 = q * 128; }
    else if (nt < 37) { int q = nt - 29; col0 = 3608 + q * 128; g.emode = E_RK; g.dst = ws + WS_RK; g.e0 = 1024; g.e1 = q * 128; }
    else if (nt < 45) { int q = nt - 37; col0 = 4632 + q * 128; g.emode = E_VT; g.dst = ws + WS_RVT; g.e0 = 8; g.e1 = q; }
    else { int q = nt - 45; col0 = 5656 + q * 128; g.emode = E_SILU; g.dst = ws + WS_RGS; g.e0 = 1024; g.e1 = q * 128; }
    g.B = W + (size_t)col0 * 2048;
}

template <int MODE>
DI void attn_item(const P& p, int it, char* smem) {
    size_t wsoff_ = 0; asm volatile("" : "+s"(wsoff_)); char* ws = p.ws + wsoff_;
    const int lane = TID() & 63, w = TID() >> 6, r = lane & 31, h = lane >> 5;
    const int b = it >> 7, g = (it >> 6) & 1, qb = it & 63, q0 = qb * 32;
    const int hq = g * 4 + w;
    const u16* Q = (const u16*)(ws + WS_QR);
    const u16* K = (const u16*)(ws + (MODE == 0 ? WS_KW : WS_KS));
    const u16* VT = (const u16*)(ws + (MODE == 0 ? WS_VWT : WS_VST)) + (size_t)(b * 2 + g) * 128 * 2048;
    const int qpos = q0 + r;
    const size_t tq = (size_t)b * 2048 + qpos;
    bf16x8 qf[8];
#pragma unroll
    for (int ks = 0; ks < 8; ++ks) qf[ks] = ldfrag(Q + tq * 1024 + hq * 128 + ks * 16 + h * 8);
    unsigned selm = 0xffffffffu, um = 0xffffffffu;
    if (MODE == 1) {
        selm = ((const unsigned*)(ws + WS_SEL))[(size_t)(b * 2 + g) * 2048 + qpos];
        um = selm;
        for (int o = 1; o <= 16; o <<= 1) um |= __shfl_xor(um, o);
    }
    f32x16 o[4];
#pragma unroll
    for (int db = 0; db < 4; ++db) o[db] = zero16();
    float m = NEG, l = 0.f;
    unsigned tmask;
    {
        const int cur = q0 >> 6;
        const unsigned upto = (cur == 31) ? 0xffffffffu : ((1u << (cur + 1)) - 1u);
        if (MODE == 0) { int lo = q0 - 512; if (lo < 0) lo = 0; lo >>= 6; tmask = upto & ~((1u << lo) - 1u); }
        else tmask = (unsigned)__builtin_amdgcn_readfirstlane((int)um) & upto;
    }
    u16* Ks = (u16*)smem;
    u16* Vs = (u16*)(smem + 17408);
    const int tid = TID();
    const u16* Kg = K + ((size_t)b * 2048 + (tid >> 4)) * 256 + g * 128 + (tid & 15) * 8;
    const u16* Vg = VT + (size_t)(tid >> 3) * 2048 + (tid & 7) * 8;
    u32x4 kr0, kr1, kr2, kr3, vr0, vr1, vr2, vr3;
#define ALOAD(tile_) do { const u16* kq_ = Kg + (size_t)(tile_) * 64 * 256; const u16* vq_ = Vg + (tile_) * 64; \
        kr0 = *(const u32x4*)(kq_); kr1 = *(const u32x4*)(kq_ + 16 * 256); kr2 = *(const u32x4*)(kq_ + 32 * 256); kr3 = *(const u32x4*)(kq_ + 48 * 256); \
        vr0 = *(const u32x4*)(vq_); vr1 = *(const u32x4*)(vq_ + 32 * 2048); vr2 = *(const u32x4*)(vq_ + 64 * 2048); vr3 = *(const u32x4*)(vq_ + 96 * 2048); } while (0)
#define ASTORE() do { u16* kd_ = Ks + (tid >> 4) * 136 + (tid & 15) * 8; u16* vd_ = Vs + (tid >> 3) * 72 + (tid & 7) * 8; \
        *(u32x4*)(kd_) = kr0; *(u32x4*)(kd_ + 16 * 136) = kr1; *(u32x4*)(kd_ + 32 * 136) = kr2; *(u32x4*)(kd_ + 48 * 136) = kr3; \
        *(u32x4*)(vd_) = vr0; *(u32x4*)(vd_ + 32 * 72) = vr1; *(u32x4*)(vd_ + 64 * 72) = vr2; *(u32x4*)(vd_ + 96 * 72) = vr3; } while (0)
    int tile = __builtin_ctz(tmask); tmask &= tmask - 1u;
    ALOAD(tile);
    __syncthreads();
    ASTORE();
    __syncthreads();
    for (;;) {
        const bool more = tmask != 0u;
        const int ntile = more ? __builtin_ctz(tmask) : tile;
        tmask &= tmask - 1u;
        if (more) ALOAD(ntile);
        const bool full = (MODE == 0) ? ((tile * 64 + 63 <= q0) && ((q0 + 31) - tile * 64 < 512)) : (tile * 64 + 63 <= q0);
        const bool selbit = (MODE == 1) ? (((selm >> tile) & 1u) != 0u) : true;
#pragma unroll
        for (int sub = 0; sub < 2; ++sub) {
            const int kp0 = tile * 64 + sub * 32;
            if (kp0 > q0 + 31) continue;
            f32x16 s = zero16();
#pragma unroll
            for (int ks = 0; ks < 8; ++ks) s = MFMA(*(const bf16x8*)&Ks[(sub * 32 + r) * 136 + ks * 16 + h * 8], qf[ks], s);
            constexpr float C2 = 0.12751743074602467f;
            float pv[16];
            float mx = NEG;
            float ps = 0.f;
            float mn, corr;
            const float m_old = m;
            if (full) {
#pragma unroll
                for (int i = 0; i < 16; ++i) { const float t = s[i] * C2; pv[i] = t; mx = fmaxf(mx, t); }
                if (MODE == 1) mx = selbit ? mx : NEG;
                mx = fmaxf(mx, __shfl_xor(mx, 32));
                mn = fmaxf(m, mx);
                corr = __builtin_amdgcn_exp2f(m - mn);
#pragma unroll
                for (int i = 0; i < 16; ++i) { float e = __builtin_amdgcn_exp2f(pv[i] - mn); if (MODE == 1) e = selbit ? e : 0.f; pv[i] = e; ps += e; }
            } else {
                bool okv[16];
#pragma unroll
                for (int i = 0; i < 16; ++i) {
                    const int key = kp0 + crow(i, h);
                    bool ok = key <= qpos;
                    if (MODE == 0) ok = ok && (qpos - key < 512);
                    else ok = ok && selbit;
                    okv[i] = ok;
                    const float t = ok ? s[i] * C2 : NEG;
                    pv[i] = t; mx = fmaxf(mx, t);
                }
                mx = fmaxf(mx, __shfl_xor(mx, 32));
                mn = fmaxf(m, mx);
                corr = __builtin_amdgcn_exp2f(m - mn);
#pragma unroll
                for (int i = 0; i < 16; ++i) { float e = okv[i] ? __builtin_amdgcn_exp2f(pv[i] - mn) : 0.f; pv[i] = e; ps += e; }
            }
            l = l * corr + ps; m = mn;
            if (__builtin_amdgcn_ballot_w64(mn > m_old) != 0ull) {
#pragma unroll
                for (int db = 0; db < 4; ++db)
#pragma unroll
                    for (int i = 0; i < 16; ++i) o[db][i] *= corr;
            }
            bf16x8 pf0 = pack8(pv[0], pv[1], pv[2], pv[3], pv[4], pv[5], pv[6], pv[7]);
            bf16x8 pf1 = pack8(pv[8], pv[9], pv[10], pv[11], pv[12], pv[13], pv[14], pv[15]);
#pragma unroll
            for (int db = 0; db < 4; ++db) {
                const u16* vp = Vs + (db * 32 + r) * 72 + sub * 32 + 4 * h;
                o[db] = MFMA(ld2x8(vp, vp + 8), pf0, o[db]);
                o[db] = MFMA(ld2x8(vp + 16, vp + 24), pf1, o[db]);
            }
        }
        if (!more) break;
        __syncthreads();
        ASTORE();
        __syncthreads();
        tile = ntile;
    }
#undef ALOAD
#undef ASTORE
    l += __shfl_xor(l, 32);
    const float inv = 1.f / l;
    const float* gates = (const float*)(ws + WS_GATES);
    const float gt = gates[tq * 24 + hq * 3 + (MODE == 0 ? 2 : 1)] * inv;
    float* onsa = (float*)(ws + WS_ONSA);
    u16* mix = (u16*)(ws + WS_MIX);
#pragma unroll
    for (int db = 0; db < 4; ++db)
#pragma unroll
        for (int a = 0; a < 4; ++a) {
            const int d = db * 32 + 8 * a + 4 * h;
            float4* op = (float4*)&onsa[tq * 1024 + hq * 128 + d];
            float4 v = make_float4(o[db][4 * a] * gt, o[db][4 * a + 1] * gt, o[db][4 * a + 2] * gt, o[db][4 * a + 3] * gt);
            if (MODE == 0) *op = v;
            else {
                float4 pr = *op;
                float4 pc = *(const float4*)((const float*)(ws + WS_OC) + tq * 1024 + hq * 128 + d);
                u32x2 ov; ov[0] = pk2(pr.x + pc.x + v.x, pr.y + pc.y + v.y); ov[1] = pk2(pr.z + pc.z + v.z, pr.w + pc.w + v.w);
                *(u32x2*)&mix[tq * 2048 + hq * 128 + d] = ov;
            }
        }
}

DI void cmp_item(const P& p, int it, char* smem) {
    size_t wsoff_ = 0; asm volatile("" : "+s"(wsoff_)); char* ws = p.ws + wsoff_;
    const int tid = TID(), lane = tid & 63, w = tid >> 6, r = lane & 31, h = lane >> 5;
    const int b = it >> 7, g = (it >> 6) & 1, qb = it & 63, q0 = qb * 32;
    const int hq = g * 4 + w;
    const u16* Q = (const u16*)(ws + WS_QN);
    const u16* K = (const u16*)(ws + WS_KCMP) + (size_t)(b * 2 + g) * 128 * 128;
    const u16* VT = (const u16*)(ws + WS_VCMPT) + (size_t)(b * 2 + g) * 128 * 128;
    const int qpos = q0 + r;
    const size_t tq = (size_t)b * 2048 + qpos;
    float* impb = (float*)smem;
    float* scb = (float*)(smem + 16384);
    __syncthreads();
    bf16x8 qf[8];
#pragma unroll
    for (int ks = 0; ks < 8; ++ks) qf[ks] = ldfrag(Q + tq * 1024 + hq * 128 + ks * 16 + h * 8);
    f32x16 s[4];
    float mx = NEG;
#pragma unroll
    for (int kb = 0; kb < 4; ++kb) {
        s[kb] = zero16();
        const u16* kp = K + (size_t)(kb * 32 + r) * 128 + h * 8;
#pragma unroll
        for (int ks = 0; ks < 8; ++ks) s[kb] = MFMA(ldfrag(kp + ks * 16), qf[ks], s[kb]);
#pragma unroll
        for (int i = 0; i < 16; ++i) {
            const int n = kb * 32 + crow(i, h);
            const bool vis = (n < 127) && (16 * n + 31 <= qpos);
            float v = vis ? s[kb][i] * SC128 : NEG;
            s[kb][i] = v; mx = fmaxf(mx, v);
        }
    }
    mx = fmaxf(mx, __shfl_xor(mx, 32));
    float sum = 0.f;
#pragma unroll
    for (int kb = 0; kb < 4; ++kb)
#pragma unroll
        for (int i = 0; i < 16; ++i) {
            const int n = kb * 32 + crow(i, h);
            const bool vis = (n < 127) && (16 * n + 31 <= qpos);
            float e = vis ? __expf(s[kb][i] - mx) : 0.f;
            s[kb][i] = e; sum += e;
        }
    sum += __shfl_xor(sum, 32);
    const float inv = sum > 0.f ? 1.f / sum : 0.f;
#pragma unroll
    for (int kb = 0; kb < 4; ++kb)
#pragma unroll
        for (int i = 0; i < 16; ++i) s[kb][i] *= inv;
    {
        float G[4][4], lastp[4][4];
#pragma unroll
        for (int kb = 0; kb < 4; ++kb)
#pragma unroll
            for (int a = 0; a < 4; ++a) {
                G[kb][a] = s[kb][4 * a] + s[kb][4 * a + 1] + s[kb][4 * a + 2] + s[kb][4 * a + 3];
                lastp[kb][a] = __shfl_xor(s[kb][4 * a + 3], 32);
            }
#pragma unroll
        for (int kb = 0; kb < 4; ++kb)
#pragma unroll
            for (int a = 0; a < 4; ++a) {
                const int j = 8 * kb + 2 * a + h;
                float prevl;
                if (a > 0) prevl = lastp[kb][a - 1]; else if (kb > 0) prevl = lastp[kb - 1][3]; else prevl = 0.f;
                float add = h ? lastp[kb][a] : prevl;
                impb[(w * 32 + r) * 32 + j] = G[kb][a] + add;
            }
    }
    __builtin_amdgcn_sched_barrier(0);
    f32x16 o[4];
#pragma unroll
    for (int db = 0; db < 4; ++db) o[db] = zero16();
#pragma unroll
    for (int kb = 0; kb < 4; ++kb) {
        __builtin_amdgcn_sched_barrier(0);
        bf16x8 pf0 = pack8(s[kb][0], s[kb][1], s[kb][2], s[kb][3], s[kb][4], s[kb][5], s[kb][6], s[kb][7]);
        bf16x8 pf1 = pack8(s[kb][8], s[kb][9], s[kb][10], s[kb][11], s[kb][12], s[kb][13], s[kb][14], s[kb][15]);
#pragma unroll
        for (int db = 0; db < 4; ++db) {
            const u16* vp = VT + (size_t)(db * 32 + r) * 128 + kb * 32 + 4 * h;
            o[db] = MFMA(ld2x8(vp, vp + 8), pf0, o[db]);
            o[db] = MFMA(ld2x8(vp + 16, vp + 24), pf1, o[db]);
        }
    }
    {
        const float* gates = (const float*)(ws + WS_GATES);
        const float gt = gates[tq * 24 + hq * 3 + 0];
        float* onsa = (float*)(ws + WS_OC);
#pragma unroll
        for (int db = 0; db < 4; ++db)
#pragma unroll
            for (int a = 0; a < 4; ++a) {
                const int d = db * 32 + 8 * a + 4 * h;
                float4* op = (float4*)&onsa[tq * 1024 + hq * 128 + d];
                float4 pr;
                pr.x = o[db][4 * a] * gt; pr.y = o[db][4 * a + 1] * gt; pr.z = o[db][4 * a + 2] * gt; pr.w = o[db][4 * a + 3] * gt;
                *op = pr;
            }
    }
    __syncthreads();
    unsigned* selo = (unsigned*)(ws + WS_SEL) + (size_t)(b * 2 + g) * 2048;
#pragma unroll
    for (int itq = 0; itq < 4; ++itq) {
        const int q = w * 8 + itq * 2 + h;
        const int t = q0 + q, cur = t >> 6, j = r;
        float sc = impb[(0 * 32 + q) * 32 + j] + impb[(1 * 32 + q) * 32 + j] + impb[(2 * 32 + q) * 32 + j] + impb[(3 * 32 + q) * 32 + j];
        const bool forced = (j == 0) || (j == cur) || (j == cur - 1);
        if (forced) sc = 1e9f;
        if (!(j * 64 <= t)) sc = -1.f;
        scb[q * 32 + j] = sc;
        CBAR();
        int cnt = 0;
#pragma unroll
        for (int j2 = 0; j2 < 32; j2 += 4) {
            float4 x = *(const float4*)&scb[q * 32 + j2];
            cnt += (x.x > sc) || (x.x == sc && (j2 + 0) < j);
            cnt += (x.y > sc) || (x.y == sc && (j2 + 1) < j);
            cnt += (x.z > sc) || (x.z == sc && (j2 + 2) < j);
            cnt += (x.w > sc) || (x.w == sc && (j2 + 3) < j);
        }
        unsigned long long bal = __ballot(cnt < 16);
        unsigned mk = h ? (unsigned)(bal >> 32) : (unsigned)bal;
        if (r == 0) selo[t] = mk;
    }
}

DI void retstate_item(const P& p, int it) {
    size_t wsoff_ = 0; asm volatile("" : "+s"(wsoff_)); char* ws = p.ws + wsoff_;
    const int lane = TID() & 63, w = TID() >> 6, r = lane & 31, h = lane >> 5;
    const int c = it & 15, bh = it >> 4;
    const u16* VT = (const u16*)(ws + WS_RVT) + (size_t)bh * 128 * 2048 + c * 128;
    const u16* KT = (const u16*)(ws + WS_RKZT) + (size_t)bh * 128 * 2048 + c * 128;
    f32x16 acc[4];
#pragma unroll
    for (int db = 0; db < 4; ++db) acc[db] = zero16();
#pragma unroll
    for (int ks = 0; ks < 8; ++ks) {
        bf16x8 a = ldfrag(VT + (size_t)(w * 32 + r) * 2048 + ks * 16 + h * 8);
#pragma unroll
        for (int db = 0; db < 4; ++db) acc[db] = MFMA(a, ldfrag(KT + (size_t)(db * 32 + r) * 2048 + ks * 16 + h * 8), acc[db]);
    }
    float* dst = (float*)(ws + WS_SST) + (size_t)it * 128 * 128;
#pragma unroll
    for (int db = 0; db < 4; ++db)
#pragma unroll
        for (int i = 0; i < 16; ++i) dst[(w * 32 + crow(i, h)) * 128 + db * 32 + r] = acc[db][i];
}

DI void cmpfin_item(const P& p, int L, int it, char* smem) {
    size_t wsoff_ = 0; asm volatile("" : "+s"(wsoff_)); char* ws = p.ws + wsoff_;
    const int tid = TID();
    const int i = it >> 7, r0 = (it & 127) * 8;
    float* biasS = (float*)smem;
    float* hS = (float*)(smem + 512);
    __syncthreads();
    if (tid < 128) {
        const float* pb = (const float*)(ws + WS_POSB) + (size_t)(L * 2 + i) * 64 * 128;
        float sacc = 0.f;
#pragma unroll 8
        for (int q = 0; q < 64; ++q) sacc += pb[q * 128 + tid];
        biasS[tid] = sacc;
    }
    __syncthreads();
    {
        const int row = tid >> 5, k4 = (tid & 31) * 4;
        const float* part = (const float*)(ws + WS_CPART) + (size_t)(i * 8) * 1024 * 128 + (size_t)(r0 + row) * 128 + k4;
        float4 a = make_float4(0.f, 0.f, 0.f, 0.f);
#pragma unroll
        for (int ksp = 0; ksp < 8; ++ksp) { float4 x = *(const float4*)(part + (size_t)ksp * 1024 * 128); a.x += x.x; a.y += x.y; a.z += x.z; a.w += x.w; }
        hS[row * 128 + k4 + 0] = gelu_erf(a.x + biasS[k4 + 0]); hS[row * 128 + k4 + 1] = gelu_erf(a.y + biasS[k4 + 1]);
        hS[row * 128 + k4 + 2] = gelu_erf(a.z + biasS[k4 + 2]); hS[row * 128 + k4 + 3] = gelu_erf(a.w + biasS[k4 + 3]);
    }
    __syncthreads();
    {
        const int n = tid & 127, rh = tid >> 7;
        const float* w2 = lnd(p.in[I_CW2]) + (size_t)(L * 2 + i) * 128 * 128;
        float acc0 = 0.f, acc1 = 0.f, acc2 = 0.f, acc3 = 0.f;
#pragma unroll 8
        for (int k = 0; k < 128; ++k) {
            const float wv = w2[k * 128 + n];
            acc0 += hS[(rh * 4 + 0) * 128 + k] * wv; acc1 += hS[(rh * 4 + 1) * 128 + k] * wv;
            acc2 += hS[(rh * 4 + 2) * 128 + k] * wv; acc3 += hS[(rh * 4 + 3) * 128 + k] * wv;
        }
        u16* kc = (u16*)(ws + WS_KCMP); u16* vt = (u16*)(ws + WS_VCMPT);
        float accs[4] = {acc0, acc1, acc2, acc3};
#pragma unroll
        for (int j = 0; j < 4; ++j) {
            const int row = r0 + rh * 4 + j;
            const int b = row >> 8, nn = (row >> 1) & 127, gg = row & 1;
            const u16 v = (nn == 127) ? (u16)0 : f2bf(accs[j]);
            if (i == 0) kc[((size_t)(b * 2 + gg) * 128 + nn) * 128 + n] = v;
            else vt[((size_t)(b * 2 + gg) * 128 + n) * 128 + nn] = v;
        }
    }
}

DI void retscan_item(const P& p, int it) {
    size_t wsoff_ = 0; asm volatile("" : "+s"(wsoff_)); char* ws = p.ws + wsoff_;
    const int tid = TID();
    const int eb = it & 15, bh = it >> 4, hh = bh & 7;
    const float log2g = log2f(1.f - exp2f(-5.f - (float)hh));
    const float cdec = exp2f(128.f * log2g);
    const int e = eb * 1024 + tid * 4;
    const float* sb = (const float*)(ws + WS_SST) + (size_t)(bh * 16) * 16384 + e;
    u16* rb = (u16*)(ws + WS_RBUF) + (size_t)(bh * 16) * 16384 + e;
    float4 x[15];
#pragma unroll
    for (int c = 0; c < 15; ++c) x[c] = *(const float4*)(sb + (size_t)c * 16384);
    float4 R = make_float4(0.f, 0.f, 0.f, 0.f);
    u32x2 z; z[0] = 0u; z[1] = 0u;
    *(u32x2*)rb = z;
#pragma unroll
    for (int c = 0; c < 15; ++c) {
        R.x = R.x * cdec + x[c].x; R.y = R.y * cdec + x[c].y; R.z = R.z * cdec + x[c].z; R.w = R.w * cdec + x[c].w;
        u32x2 pk; pk[0] = pk2(R.x, R.y); pk[1] = pk2(R.z, R.w);
        *(u32x2*)(rb + (size_t)(c + 1) * 16384) = pk;
    }
}

DI void retout_item(const P& p, int L, int it, char* smem) {
    size_t wsoff_ = 0; asm volatile("" : "+s"(wsoff_)); char* ws = p.ws + wsoff_;
    const int tid = TID(), lane = tid & 63, w = tid >> 6, r = lane & 31, h = lane >> 5;
    const int c = it & 15, bh = it >> 4, hh = bh & 7, b = bh >> 3;
    const float log2g = log2f(1.f - exp2f(-5.f - (float)hh));
    const float cdec = exp2f(128.f * log2g);
    const u16* Rt = (const u16*)(ws + WS_RBUF) + (size_t)(bh * 16 + c) * 16384;
    const int i0 = w * 32, iq = i0 + r;
    const size_t tq = (size_t)b * 2048 + c * 128 + iq;
    const u16* Q = (const u16*)(ws + WS_RQ);
    const u16* K = (const u16*)(ws + WS_RK);
    const u16* VT = (const u16*)(ws + WS_RVT) + (size_t)bh * 128 * 2048 + c * 128;
    bf16x8 qf[8];
#pragma unroll
    for (int ks = 0; ks < 8; ++ks) qf[ks] = ldfrag(Q + tq * 1024 + hh * 128 + ks * 16 + h * 8);
    f32x16 o[4];
#pragma unroll
    for (int vb = 0; vb < 4; ++vb) {
        o[vb] = zero16();
#pragma unroll
        for (int ks = 0; ks < 8; ++ks) o[vb] = MFMA(ldfrag(Rt + (vb * 32 + r) * 128 + ks * 16 + h * 8), qf[ks], o[vb]);
    }
    const float xi = exp2f((float)(iq + 1) * log2g);
#pragma unroll
    for (int vb = 0; vb < 4; ++vb)
#pragma unroll
        for (int i = 0; i < 16; ++i) o[vb][i] *= xi;
    for (int jb = 0; jb <= w; ++jb) {
        f32x16 s = zero16();
        const u16* kp = K + ((size_t)b * 2048 + c * 128 + jb * 32 + r) * 1024 + hh * 128 + h * 8;
#pragma unroll
        for (int ks = 0; ks < 8; ++ks) s = MFMA(ldfrag(kp + ks * 16), qf[ks], s);
        float pv[16];
#pragma unroll
        for (int i = 0; i < 16; ++i) {
            const int j = jb * 32 + crow(i, h);
            const int df = iq - j;
            pv[i] = (df >= 0) ? s[i] * exp2f((float)df * log2g) : 0.f;
        }
        bf16x8 pf0 = pack8(pv[0], pv[1], pv[2], pv[3], pv[4], pv[5], pv[6], pv[7]);
        bf16x8 pf1 = pack8(pv[8], pv[9], pv[10], pv[11], pv[12], pv[13], pv[14], pv[15]);
#pragma unroll
        for (int vb = 0; vb < 4; ++vb) {
            const u16* vp = VT + (size_t)(vb * 32 + r) * 2048 + jb * 32 + 4 * h;
            o[vb] = MFMA(ld2x8(vp, vp + 8), pf0, o[vb]);
            o[vb] = MFMA(ld2x8(vp + 16, vp + 24), pf1, o[vb]);
        }
    }
    float sm = 0.f;
#pragma unroll
    for (int vb = 0; vb < 4; ++vb)
#pragma unroll
        for (int i = 0; i < 16; ++i) sm += o[vb][i];
    sm += __shfl_xor(sm, 32);
    const float mu = sm * (1.f / 128.f);
    float vs = 0.f;
#pragma unroll
    for (int vb = 0; vb < 4; ++vb)
#pragma unroll
        for (int i = 0; i < 16; ++i) { float dlt = o[vb][i] - mu; vs += dlt * dlt; }
    vs += __shfl_xor(vs, 32);
    const float rs = rsqrtf(vs * (1.f / 128.f) + 1e-5f);
    const float* gg = lnd(p.in[I_GNG]) + L * 1024 + hh * 128;
    const float* gb = lnd(p.in[I_GNB]) + L * 1024 + hh * 128;
    const u16* rgs = (const u16*)(ws + WS_RGS) + tq * 1024 + hh * 128;
    u16* mix = (u16*)(ws + WS_MIX) + tq * 2048 + 1024 + hh * 128;
#pragma unroll
    for (int vb = 0; vb < 4; ++vb)
#pragma unroll
        for (int a = 0; a < 4; ++a) {
            const int v0 = vb * 32 + 8 * a + 4 * h;
            float4 g4 = *(const float4*)&gg[v0], b4 = *(const float4*)&gb[v0];
            u32x2 gt = *(const u32x2*)&rgs[v0];
            float y0 = ((o[vb][4 * a] - mu) * rs * g4.x + b4.x) * bflo(gt[0]);
            float y1 = ((o[vb][4 * a + 1] - mu) * rs * g4.y + b4.y) * bfhi(gt[0]);
            float y2 = ((o[vb][4 * a + 2] - mu) * rs * g4.z + b4.z) * bflo(gt[1]);
            float y3 = ((o[vb][4 * a + 3] - mu) * rs * g4.w + b4.w) * bfhi(gt[1]);
            u32x2 ov; ov[0] = pk2(y0, y1); ov[1] = pk2(y2, y3);
            *(u32x2*)&mix[v0] = ov;
        }
}

DI void xattn_item(const P& p, int it, char* smem) {
    size_t wsoff_ = 0; asm volatile("" : "+s"(wsoff_)); char* ws = p.ws + wsoff_;
    const int tid = TID(), lane = tid & 63, w = tid >> 6, r = lane & 31, h = lane >> 5;
    const int qb = it & 31, head = (it >> 5) & 3, b = it >> 7;
    const size_t t0 = (size_t)b * 2048 + qb * 64;
    const u16* Qg = (const u16*)(ws + WS_XQ) + t0 * 2048 + head * 512;
    const u16* Kg = (const u16*)(ws + WS_XK) + (size_t)(b * 256) * 2048 + head * 512;
    u16* Kc = (u16*)smem;
    u16* Qc = (u16*)(smem + 36864);
    float* mxs = (float*)(smem + 46080);
    float* sms = mxs + 256;
    u16* Pq = (u16*)smem;
    const u16* kgp = Kg + (size_t)(tid >> 3) * 2048 + (tid & 7) * 8;
    const u16* qgp = Qg + (size_t)(tid >> 3) * 2048 + (tid & 7) * 8;
    u32x4 kr[8], qr[2];
    f32x16 s[2][2];
#pragma unroll
    for (int a = 0; a < 2; ++a)
#pragma unroll
        for (int c = 0; c < 2; ++c) s[a][c] = zero16();
#define XLOAD(dc_) do { _Pragma("unroll") for (int i = 0; i < 8; ++i) kr[i] = *(const u32x4*)(kgp + (size_t)(i * 32) * 2048 + (dc_) * 64); \
        qr[0] = *(const u32x4*)(qgp + (dc_) * 64); qr[1] = *(const u32x4*)(qgp + (size_t)32 * 2048 + (dc_) * 64); } while (0)
#define XSTORE() do { _Pragma("unroll") for (int i = 0; i < 8; ++i) *(u32x4*)&Kc[((tid >> 3) + i * 32) * 72 + (tid & 7) * 8] = kr[i]; \
        *(u32x4*)&Qc[(tid >> 3) * 72 + (tid & 7) * 8] = qr[0]; *(u32x4*)&Qc[((tid >> 3) + 32) * 72 + (tid & 7) * 8] = qr[1]; } while (0)
    XLOAD(0);
    __syncthreads();
    XSTORE();
    __syncthreads();
#pragma unroll 1
    for (int dc = 0; dc < 8; ++dc) {
        if (dc + 1 < 8) XLOAD(dc + 1);
#pragma unroll
        for (int ks = 0; ks < 4; ++ks) {
            bf16x8 kf0 = *(const bf16x8*)&Kc[(w * 64 + r) * 72 + ks * 16 + h * 8];
            bf16x8 kf1 = *(const bf16x8*)&Kc[(w * 64 + 32 + r) * 72 + ks * 16 + h * 8];
            bf16x8 qf0 = *(const bf16x8*)&Qc[r * 72 + ks * 16 + h * 8];
            bf16x8 qf1 = *(const bf16x8*)&Qc[(32 + r) * 72 + ks * 16 + h * 8];
            s[0][0] = MFMA(kf0, qf0, s[0][0]); s[0][1] = MFMA(kf0, qf1, s[0][1]);
            s[1][0] = MFMA(kf1, qf0, s[1][0]); s[1][1] = MFMA(kf1, qf1, s[1][1]);
        }
        __syncthreads();
        if (dc + 1 < 8) { XSTORE(); __syncthreads(); }
    }
#undef XLOAD
#undef XSTORE
#pragma unroll
    for (int qg = 0; qg < 2; ++qg) {
        float mx = NEG;
#pragma unroll
        for (int kb = 0; kb < 2; ++kb)
#pragma unroll
            for (int i = 0; i < 16; ++i) { s[kb][qg][i] *= SC512; mx = fmaxf(mx, s[kb][qg][i]); }
        mx = fmaxf(mx, __shfl_xor(mx, 32));
        if (h == 0) mxs[w * 64 + qg * 32 + r] = mx;
    }
    __syncthreads();
    float linv[2];
#pragma unroll
    for (int qg = 0; qg < 2; ++qg) {
        const int q = qg * 32 + r;
        const float gm = fmaxf(fmaxf(mxs[q], mxs[64 + q]), fmaxf(mxs[128 + q], mxs[192 + q]));
        float sum = 0.f;
#pragma unroll
        for (int kb = 0; kb < 2; ++kb) {
#pragma unroll
            for (int i = 0; i < 16; ++i) { float e = __expf(s[kb][qg][i] - gm); s[kb][qg][i] = e; sum += e; }
#pragma unroll
            for (int a = 0; a < 4; ++a) {
                u32x2 v; v[0] = pk2(s[kb][qg][4 * a], s[kb][qg][4 * a + 1]); v[1] = pk2(s[kb][qg][4 * a + 2], s[kb][qg][4 * a + 3]);
                *(u32x2*)&Pq[q * 264 + w * 64 + kb * 32 + 8 * a + 4 * h] = v;
            }
        }
        sum += __shfl_xor(sum, 32);
        if (h == 0) sms[w * 64 + q] = sum;
    }
    __syncthreads();
#pragma unroll
    for (int qg = 0; qg < 2; ++qg) { const int q = qg * 32 + r; linv[qg] = 1.f / (sms[q] + sms[64 + q] + sms[128 + q] + sms[192 + q]); }
    const u16* VT = (const u16*)(ws + WS_XVT) + (size_t)((b * 4 + head) * 512 + w * 128) * 256;
    f32x16 o[4][2];
#pragma unroll
    for (int db = 0; db < 4; ++db) { o[db][0] = zero16(); o[db][1] = zero16(); }
#pragma unroll 4
    for (int kk = 0; kk < 16; ++kk) {
        bf16x8 pf0 = *(const bf16x8*)&Pq[r * 264 + kk * 16 + h * 8];
        bf16x8 pf1 = *(const bf16x8*)&Pq[(32 + r) * 264 + kk * 16 + h * 8];
#pragma unroll
        for (int db = 0; db < 4; ++db) {
            bf16x8 vf = ldfrag(VT + (size_t)(db * 32 + r) * 256 + kk * 16 + h * 8);
            o[db][0] = MFMA(vf, pf0, o[db][0]);
            o[db][1] = MFMA(vf, pf1, o[db][1]);
        }
    }
#pragma unroll
    for (int qg = 0; qg < 2; ++qg) {
        u16* xo = (u16*)(ws + WS_XO) + (t0 + qg * 32 + r) * 2048 + head * 512 + w * 128;
#pragma unroll
        for (int db = 0; db < 4; ++db)
#pragma unroll
            for (int a = 0; a < 4; ++a) {
                const int d = db * 32 + 8 * a + 4 * h;
                u32x2 ov; ov[0] = pk2(o[db][qg][4 * a] * linv[qg], o[db][qg][4 * a + 1] * linv[qg]); ov[1] = pk2(o[db][qg][4 * a + 2] * linv[qg], o[db][qg][4 * a + 3] * linv[qg]);
                *(u32x2*)&xo[d] = ov;
            }
    }
}

template <int NC, int NJ>
DI void ln_row_store(float (&y)[NC][NJ], const float* gam, const float* bet, float* dstf, u16* dstb, int lane) {
    float sm = 0.f;
#pragma unroll
    for (int c = 0; c < NC; ++c)
#pragma unroll
        for (int j = 0; j < NJ; ++j) sm += y[c][j];
    const float mu = wave_sum(sm) * (1.f / 2048.f);
    float vs = 0.f;
#pragma unroll
    for (int c = 0; c < NC; ++c)
#pragma unroll
        for (int j = 0; j < NJ; ++j) { float d = y[c][j] - mu; vs += d * d; }
    const float rs = rsqrtf(wave_sum(vs) * (1.f / 2048.f) + 1e-5f);
#pragma unroll
    for (int c = 0; c < NC; ++c)
#pragma unroll
        for (int j8 = 0; j8 < NJ; j8 += 8) {
            const int col = (c * 64 + lane) * NJ + j8;
            float4 g0 = *(const float4*)&gam[col], g1 = *(const float4*)&gam[col + 4];
            float4 b0 = *(const float4*)&bet[col], b1 = *(const float4*)&bet[col + 4];
            float4 o0, o1;
            o0.x = (y[c][j8 + 0] - mu) * rs * g0.x + b0.x; o0.y = (y[c][j8 + 1] - mu) * rs * g0.y + b0.y;
            o0.z = (y[c][j8 + 2] - mu) * rs * g0.z + b0.z; o0.w = (y[c][j8 + 3] - mu) * rs * g0.w + b0.w;
            o1.x = (y[c][j8 + 4] - mu) * rs * g1.x + b1.x; o1.y = (y[c][j8 + 5] - mu) * rs * g1.y + b1.y;
            o1.z = (y[c][j8 + 6] - mu) * rs * g1.z + b1.z; o1.w = (y[c][j8 + 7] - mu) * rs * g1.w + b1.w;
            *(float4*)&dstf[col] = o0; *(float4*)&dstf[col + 4] = o1;
            u32x4 pb = {pk2(o0.x, o0.y), pk2(o0.z, o0.w), pk2(o1.x, o1.y), pk2(o1.z, o1.w)};
            *(u32x4*)&dstb[col] = pb;
        }
}

DI void ln_phase(const P& p, const float* gam, const float* bet) {
    size_t wsoff_ = 0; asm volatile("" : "+s"(wsoff_)); char* ws = p.ws + wsoff_;
    const int lane = TID() & 63, w = TID() >> 6;
    const float* y = (const float*)(ws + WS_Y);
    float* xf = (float*)(ws + WS_XF); u16* xb = (u16*)(ws + WS_XB);
    for (int t = BID() * 4 + w; t < T; t += GDIM() * 4) {
        float v[4][8];
#pragma unroll
        for (int c = 0; c < 4; ++c) {
            const int col = (c * 64 + lane) * 8;
            float4 a = *(const float4*)&y[(size_t)t * 2048 + col], bq = *(const float4*)&y[(size_t)t * 2048 + col + 4];
            v[c][0] = a.x; v[c][1] = a.y; v[c][2] = a.z; v[c][3] = a.w; v[c][4] = bq.x; v[c][5] = bq.y; v[c][6] = bq.z; v[c][7] = bq.w;
        }
        ln_row_store(v, gam, bet, xf + (size_t)t * 2048, xb + (size_t)t * 2048, lane);
    }
}

DI unsigned fkey(float x) { unsigned u = __float_as_uint(x); return u ^ ((unsigned)((int)u >> 31) | 0x80000000u); }
DI int mbcnt64(unsigned long long m) { return __builtin_amdgcn_mbcnt_hi((unsigned)(m >> 32), __builtin_amdgcn_mbcnt_lo((unsigned)m, 0u)); }
DI float fkeyinv(unsigned k) { return __uint_as_float((k & 0x80000000u) ? (k ^ 0x80000000u) : ~k); }
template <bool TWO>
DI void wave_top16(unsigned k0, unsigned k1, unsigned pay0, unsigned pay1, int lane, unsigned* kk, unsigned* ki, unsigned* kp, int& rank, unsigned& okey, unsigned& opay) {
    unsigned T = 0u; int cntT = 1000;
#pragma unroll 1
    for (int bit = 31; bit >= 0; --bit) {
        const unsigned c = T | (1u << bit);
        int cnt = __builtin_popcountll(__builtin_amdgcn_ballot_w64(k0 >= c));
        if (TWO) cnt += __builtin_popcountll(__builtin_amdgcn_ballot_w64(k1 >= c));
        if (cnt >= 16) { T = c; cntT = cnt; if (cnt == 16) break; }
    }
    bool sel0, sel1;
    if (cntT == 16) { sel0 = k0 >= T; sel1 = TWO && (k1 >= T); }
    else {
        const bool gt0 = k0 > T, eq0 = k0 == T, gt1 = TWO && (k1 > T), eq1 = TWO && (k1 == T);
        const unsigned long long bg0 = __builtin_amdgcn_ballot_w64(gt0), bg1 = __builtin_amdgcn_ballot_w64(gt1);
        const unsigned long long be0 = __builtin_amdgcn_ballot_w64(eq0), be1 = __builtin_amdgcn_ballot_w64(eq1);
        const int need = 16 - (__builtin_popcountll(bg0) + __builtin_popcountll(bg1));
        sel0 = gt0 || (eq0 && mbcnt64(be0) < need);
        sel1 = gt1 || (eq1 && (__builtin_popcountll(be0) + mbcnt64(be1)) < need);
    }
    const unsigned long long bs0 = __builtin_amdgcn_ballot_w64(sel0), bs1 = __builtin_amdgcn_ballot_w64(sel1);
    CBAR();
    if (sel0) { const int sl = mbcnt64(bs0); kk[sl] = k0; ki[sl] = (unsigned)lane; kp[sl] = pay0; }
    if (sel1) { const int sl = __builtin_popcountll(bs0) + mbcnt64(bs1); kk[sl] = k1; ki[sl] = (unsigned)(lane + 64); kp[sl] = pay1; }
    CBAR();
    const int me = lane & 15;
    const unsigned myk = kk[me], myi = ki[me];
    opay = kp[me]; okey = myk;
    int c = 0;
#pragma unroll
    for (int j = 0; j < 16; j += 4) {
        const u32x4 a = *(const u32x4*)&kk[j]; const u32x4 bq = *(const u32x4*)&ki[j];
#pragma unroll
        for (int q = 0; q < 4; ++q) c += (a[q] > myk) || (a[q] == myk && bq[q] < myi);
    }
    CBAR();
    rank = c;
}

DI void peer_phase(const P& p, int L, char* smem, float* outp) {
    size_t wsoff_ = 0; asm volatile("" : "+s"(wsoff_)); char* ws = p.ws + wsoff_;
    const int lane = TID() & 63, w = TID() >> 6;
    char* wl = smem + w * 4096;
    float* sc = (float*)wl;
    float* s1s = sc + 128; int* i1s = (int*)(s1s + 16); float* s2s = (float*)(i1s + 16); int* i2s = (int*)(s2s + 16);
    float* cv = (float*)(i2s + 16);
    int* cp = (int*)(cv + 64);
    float* tv = (float*)(cp + 64);
    int* te = (int*)(tv + 16);
    int* exl = te + 16;
    float* gx = (float*)(exl + 128);
    const float* scores = (const float*)(ws + WS_SCORES);
    float* xf = (float*)(ws + WS_XF); u16* xb = (u16*)(ws + WS_XB);
    const unsigned char* ub = (const unsigned char*)(ws + WS_UB) + (size_t)L * 16384 * 1536;
    const unsigned char* vb = (const unsigned char*)(ws + WS_VB) + (size_t)L * 16384 * 1536;
    const float* gam = lnd(p.in[I_LN3G]) + L * 2048; const float* bet = lnd(p.in[I_LN3B]) + L * 2048;
    const int lane0 = lane;
    float n00 = 0.f, n01 = 0.f, n10 = 0.f, n11 = 0.f;
    const int tfirst = BID() * 4 + w;
    for (int t = tfirst; t < T; t += GDIM() * 4) {
        int lane = lane0; asm volatile("" : "+v"(lane));
        int ca = 0, cb = lane;
        { int a = 0, rem = lane; for (; a < 16; ++a) { int cnt = 16 / (a + 1); if (rem < cnt) break; rem -= cnt; } ca = a; cb = rem; }
        const bool cvalid = ca < 16;
        const float* srow = scores + (size_t)t * 2048 + lane;
        if (t == tfirst) { n00 = srow[0]; n01 = srow[64]; n10 = srow[128]; n11 = srow[192]; }
        for (int hd2 = 0; hd2 < 8 * TOPK_REP; ++hd2) { const int hd = hd2 & 7;
            const float c00 = n00, c01 = n01, c10 = n10, c11 = n11;
            {
                const int tn = (t + GDIM() * 4 < T) ? t + GDIM() * 4 : t;
                const float* nrow = (hd2 == 8 * TOPK_REP - 1) ? (scores + (size_t)tn * 2048 + lane) : (srow + ((hd2 + 1) & 7) * 256);
                n00 = nrow[0]; n01 = nrow[64]; n10 = nrow[128]; n11 = nrow[192];
            }
            for (int p2 = 0; p2 < 2; ++p2) {
                const float v0 = p2 ? c10 : c00, v1 = p2 ? c11 : c01;
                int rk; unsigned ok, op;
                wave_top16<true>(fkey(v0), fkey(v1), (unsigned)lane, (unsigned)(lane + 64), lane, (unsigned*)cv, (unsigned*)cp, (unsigned*)cv + 16, rk, ok, op);
                float* ss = p2 ? s2s : s1s; int* is = p2 ? i2s : i1s;
                if (lane < 16) { ss[rk] = fkeyinv(ok); is[rk] = (int)op; }
                CBAR();
            }
            float val = 0.f; int eid = 0; unsigned ckey = 0u;
            if (cvalid) { val = s1s[ca] + s2s[cb]; eid = i1s[ca] * 128 + i2s[cb]; ckey = fkey(val); }
            CBAR();
            {
                int rk; unsigned ok, op;
                wave_top16<false>(ckey, 0u, (unsigned)eid, 0u, lane, (unsigned*)cv, (unsigned*)cp, (unsigned*)cv + 16, rk, ok, op);
                if (lane < 16) { tv[rk] = fkeyinv(ok); te[rk] = (int)op; }
            }
            CBAR();
            {
                const int li = lane & 15;
                const float tmax = tv[0];
                float e = __expf(tv[li] - tmax);
                float sum = e;
                sum += __shfl_xor(sum, 1); sum += __shfl_xor(sum, 2); sum += __shfl_xor(sum, 4); sum += __shfl_xor(sum, 8);
                if (lane < 16) { gx[hd * 16 + lane] = e / sum; exl[hd * 16 + lane] = te[lane]; }
            }
            CBAR();
        }
        asm volatile("" : "+v"(lane));
        float x[1][32], acc[1][32];
        const float* xr = xf + (size_t)t * 2048 + lane * 32;
#pragma unroll
        for (int q = 0; q < 8; ++q) {
            float4 a = *(const float4*)&xr[4 * q];
            x[0][4 * q] = a.x; x[0][4 * q + 1] = a.y; x[0][4 * q + 2] = a.z; x[0][4 * q + 3] = a.w;
        }
#pragma unroll
        for (int j = 0; j < 32; ++j) acc[0][j] = 0.f;
        const unsigned voff24 = (unsigned)lane * 24u;
#pragma unroll 1
        for (int k = 0; k < 128; k += 4) {
            int e[4]; float gq[4];
#pragma unroll
            for (int q = 0; q < 4; ++q) { e[q] = __builtin_amdgcn_readfirstlane(exl[k + q]); gq[q] = gx[k + q]; }
            u32x6 ua[4], va[4];
#pragma unroll
            for (int q = 0; q < 4; ++q) {
                const u32x2* sp = (const u32x2*)((ub + (size_t)e[q] * 1536) + (size_t)voff24);
                const u32x2 a0 = sp[0], a1 = sp[1], a2 = sp[2];
                ua[q][0] = a0[0]; ua[q][1] = a0[1]; ua[q][2] = a1[0]; ua[q][3] = a1[1]; ua[q][4] = a2[0]; ua[q][5] = a2[1];
            }
#pragma unroll
            for (int q = 0; q < 4; ++q) {
                const u32x2* sp = (const u32x2*)((vb + (size_t)e[q] * 1536) + (size_t)voff24);
                const u32x2 a0 = sp[0], a1 = sp[1], a2 = sp[2];
                va[q][0] = a0[0]; va[q][1] = a0[1]; va[q][2] = a1[0]; va[q][3] = a1[1]; va[q][4] = a2[0]; va[q][5] = a2[1];
            }
            float d[4];
#pragma unroll
            for (int q = 0; q < 4; ++q) {
                const f32x32 uu = __builtin_amdgcn_cvt_scalef32_pk32_f32_fp6(ua[q], 1.0f);
                float dd = 0.f;
#pragma unroll
                for (int j = 0; j < 32; ++j) dd += x[0][j] * uu[j];
                d[q] = dd;
                if (q < 3) { unsigned t0 = ua[q + 1][0]; asm volatile("" : "+v"(t0) : "v"(dd)); ua[q + 1][0] = t0; }
            }
#pragma unroll
            for (int q = 0; q < 4; ++q) d[q] = wave_sum(d[q]);
            float f[4];
#pragma unroll
            for (int q = 0; q < 4; ++q) f[q] = gq[q] * gelu_erf(d[q] * (1.f / 64.f)) * (1.f / 8.f);
#pragma unroll
            for (int q = 0; q < 4; ++q) {
                const f32x32 vv = __builtin_amdgcn_cvt_scalef32_pk32_f32_fp6(va[q], 1.0f);
#pragma unroll
                for (int j = 0; j < 32; ++j) acc[0][j] += f[q] * vv[j];
                if (q < 3) { unsigned t0 = va[q + 1][0]; asm volatile("" : "+v"(t0) : "v"(acc[0][0])); va[q + 1][0] = t0; }
            }
        }
#pragma unroll
        for (int j = 0; j < 32; ++j) acc[0][j] += ALPHA * x[0][j];
        ln_row_store<1, 32>(acc, gam, bet, outp + (size_t)t * 2048, xb + (size_t)t * 2048, lane);
    }
}

DI void prep_phase(const P& p, char* smem) {
    size_t wsoff_ = 0; asm volatile("" : "+s"(wsoff_)); char* ws = p.ws + wsoff_;
    const size_t gtid = (size_t)BID() * 256 + TID(), gsz = (size_t)GDIM() * 256;
    {
        const float* x = lnd(p.in[I_X]); u16* xb = (u16*)(ws + WS_XB);
        for (size_t i = gtid; i < (size_t)T * 2048 / 8; i += gsz) {
            float4 a = *(const float4*)&x[i * 8], b = *(const float4*)&x[i * 8 + 4];
            u32x4 o = {pk2(a.x, a.y), pk2(a.z, a.w), pk2(b.x, b.y), pk2(b.z, b.w)};
            *(u32x4*)&xb[i * 8] = o;
        }
        const float* mm = lnd(p.in[I_MEM]); u16* mb = (u16*)(ws + WS_MEMB);
        for (size_t i = gtid; i < (size_t)1024 * 2048 / 8; i += gsz) {
            float4 a = *(const float4*)&mm[i * 8], b = *(const float4*)&mm[i * 8 + 4];
            u32x4 o = {pk2(a.x, a.y), pk2(a.z, a.w), pk2(b.x, b.y), pk2(b.z, b.w)};
            *(u32x4*)&mb[i * 8] = o;
        }
    }
    {
        int* sigs = (int*)(smem + 36864);
        __syncthreads();
        {
            f32x16v pa, pbv, qa, qb;
#pragma unroll
            for (int i = 0; i < 16; ++i) { pa[i] = (float)(i & 7); pbv[i] = (float)((16 + i) & 7); qa[i] = (float)(i >> 3); qb[i] = (float)((16 + i) >> 3); }
            const u32x6 e1 = __builtin_amdgcn_cvt_scalef32_2xpk16_fp6_f32(pa, pbv, 1.0f);
            const u32x6 e2 = __builtin_amdgcn_cvt_scalef32_2xpk16_fp6_f32(qa, qb, 1.0f);
            const f32x32 d1 = __builtin_amdgcn_cvt_scalef32_pk32_f32_fp6(e1, 1.0f);
            const f32x32 d2 = __builtin_amdgcn_cvt_scalef32_pk32_f32_fp6(e2, 1.0f);
            if (TID() == 0) {
#pragma unroll
                for (int j = 0; j < 32; ++j) { const int slot = ((int)(d1[j] + 0.5f) + 8 * (int)(d2[j] + 0.5f)) & 31; sigs[slot] = j; }
            }
        }
        __syncthreads();
        __builtin_amdgcn_sched_barrier(0);
        { int lz = 0; asm volatile("" : "+v"(lz)); sigs += lz; }
        const float* u = lnd(p.in[I_PU]); const float* v = lnd(p.in[I_PV]);
        unsigned char* ub = (unsigned char*)(ws + WS_UB); unsigned char* vb = (unsigned char*)(ws + WS_VB);
        const size_t n32 = (size_t)2 * 16384 * 2048 / 32;
        const int lane_ = TID() & 63, w_ = TID() >> 6;
        float* wreg = (float*)(smem + w_ * 8448);
        for (size_t i = gtid; i < n32; i += gsz) {
            const size_t wbase = (i - (size_t)lane_) * 32;
#pragma unroll 1
            for (int tb = 0; tb < 2; ++tb) {
                const float* src = (tb ? v : u) + wbase;
                const float scl = tb ? 8.f : 64.f;
                CBAR();
#pragma unroll
                for (int k = 0; k < 8; ++k) {
                    const float4 v4 = *(const float4*)(src + (size_t)(k * 64 + lane_) * 4);
                    float* d = wreg + (k * 8 + (lane_ >> 3)) * 33 + (lane_ & 7) * 4;
                    d[0] = v4.x; d[1] = v4.y; d[2] = v4.z; d[3] = v4.w;
                }
                CBAR();
                const float* mine = wreg + lane_ * 33;
                f32x16v xa, xb2;
#pragma unroll
                for (int q = 0; q < 16; q += 4) {
                    const int4 s0 = *(const int4*)&sigs[q], s1 = *(const int4*)&sigs[16 + q];
                    xa[q] = mine[s0.x] * scl; xa[q + 1] = mine[s0.y] * scl; xa[q + 2] = mine[s0.z] * scl; xa[q + 3] = mine[s0.w] * scl;
                    xb2[q] = mine[s1.x] * scl; xb2[q + 1] = mine[s1.y] * scl; xb2[q + 2] = mine[s1.z] * scl; xb2[q + 3] = mine[s1.w] * scl;
                }
                CBAR();
                const u32x6 o = __builtin_amdgcn_cvt_scalef32_2xpk16_fp6_f32(xa, xb2, 1.0f);
                u32x2 o0 = {o[0], o[1]}, o1 = {o[2], o[3]}, o2 = {o[4], o[5]};
                u32x2* dst = (u32x2*)((tb ? vb : ub) + i * 24); dst[0] = o0; dst[1] = o1; dst[2] = o2;
            }
        }
    }
    {
        float2* tab = (float2*)(ws + WS_ROPE);
        for (size_t i = gtid; i < (size_t)2048 * 64; i += gsz) {
            const int s = (int)(i >> 6), j = (int)(i & 63);
            const float inv = 1.0f / powf(10000.f, (float)(2 * j) / 128.f);
            const float ang = (float)s * inv;
            tab[i] = make_float2(cosf(ang), sinf(ang));
        }
    }
    {
        float* tl = (float*)smem;
        const int tid = TID();
        const int per_layer = 32 * 105 + 5 * 1024 + 256;
        const int n4 = (tid & 15) * 4, kr = tid >> 4;
        const float* src = nullptr; u16* dst = nullptr; int N = 0, Kd = 0, kt = 0, nt = 0;
        const float* nsrc = nullptr; u16* ndst = nullptr; int nN = 0, nKd = 0, nkt = 0, nnt = 0;
        float4 v0, v1, v2, v3;
#define TRDESC(it_, SRC, DST, NN, KD, KT, NT) do { const int L_ = (it_) / per_layer; int q_ = (it_) - L_ * per_layer; \
            u16* wl_ = (u16*)(ws + WS_WT) + (size_t)L_ * WT_LAYER; \
            if (q_ < 32 * 105) { SRC = lnd(p.in[I_WIN]) + (size_t)L_ * 2048 * PIN; DST = wl_ + WT_IN; NN = PIN; KD = 2048; KT = q_ / 105; NT = q_ - KT * 105; } \
            else if (q_ < 32 * 105 + 5 * 1024) { \
                q_ -= 32 * 105; const int m_ = q_ >> 10; q_ &= 1023; KT = q_ >> 5; NT = q_ & 31; NN = 2048; KD = 2048; \
                const int idx_ = (m_ == 0) ? I_WOUT : (m_ == 1) ? I_XWQ : (m_ == 2) ? I_XWK : (m_ == 3) ? I_XWV : I_XWO; \
                SRC = lnd(p.in[idx_]) + (size_t)L_ * 2048 * 2048; DST = wl_ + WT_OUT + (size_t)m_ * 2048 * 2048; \
            } else { \
                q_ -= 32 * 105 + 5 * 1024; const int i_ = q_ >> 7; q_ &= 127; KT = q_ >> 1; NT = q_ & 1; NN = 128; KD = 4096; \
                SRC = lnd(p.in[I_CW1]) + (size_t)(L_ * 2 + i_) * 4096 * 128; DST = wl_ + WT_CW1 + (size_t)i_ * 128 * 4096; \
            } } while (0)
#define TRLOAD(SRC, NN, KT, NT) do { const int n_ = (NT) * 64 + n4; const float4 z_ = make_float4(0.f, 0.f, 0.f, 0.f); v0 = z_; v1 = z_; v2 = z_; v3 = z_; \
            if (n_ < (NN)) { const float* b_ = (SRC) + (size_t)((KT) * 64 + kr) * (NN) + n_; \
                v0 = *(const float4*)(b_); v1 = *(const float4*)(b_ + (size_t)16 * (NN)); v2 = *(const float4*)(b_ + (size_t)32 * (NN)); v3 = *(const float4*)(b_ + (size_t)48 * (NN)); } } while (0)
        const int total = 2 * per_layer;
        int it = BID();
        if (it < total) { TRDESC(it, src, dst, N, Kd, kt, nt); TRLOAD(src, N, kt, nt); }
        for (; it < total; it += GDIM()) {
            const bool hn = it + GDIM() < total;
            __syncthreads();
            {
                float* t0 = tl + kr * 65 + n4;
                t0[0] = v0.x; t0[1] = v0.y; t0[2] = v0.z; t0[3] = v0.w;
                t0[16 * 65 + 0] = v1.x; t0[16 * 65 + 1] = v1.y; t0[16 * 65 + 2] = v1.z; t0[16 * 65 + 3] = v1.w;
                t0[32 * 65 + 0] = v2.x; t0[32 * 65 + 1] = v2.y; t0[32 * 65 + 2] = v2.z; t0[32 * 65 + 3] = v2.w;
                t0[48 * 65 + 0] = v3.x; t0[48 * 65 + 1] = v3.y; t0[48 * 65 + 2] = v3.z; t0[48 * 65 + 3] = v3.w;
            }
            if (hn) { TRDESC(it + GDIM(), nsrc, ndst, nN, nKd, nkt, nnt); TRLOAD(nsrc, nN, nkt, nnt); }
            __syncthreads();
#pragma unroll
            for (int i2 = 0; i2 < 2; ++i2) {
                const int c = tid + 256 * i2, n = c >> 3, kc = c & 7;
                if (nt * 64 + n < N) {
                    const float* tp = tl + (kc * 8) * 65 + n;
                    u32x4 o = {pk2(tp[0], tp[65]), pk2(tp[130], tp[195]), pk2(tp[260], tp[325]), pk2(tp[390], tp[455])};
                    *(u32x4*)&dst[(size_t)(nt * 64 + n) * Kd + kt * 64 + kc * 8] = o;
                }
            }
            src = nsrc; dst = ndst; N = nN; Kd = nKd; kt = nkt; nt = nnt;
        }
#undef TRDESC
#undef TRLOAD
    }
    {
        float* pb = (float*)(ws + WS_POSB);
        for (int it = BID(); it < 2 * 2 * 32; it += GDIM()) {
            const int part = it & 31, li = it >> 5;
            const int col = TID() & 127, half = TID() >> 7;
            const float* pos = lnd(p.in[I_CPOS]) + (size_t)li * 4096;
            const float* w1 = lnd(p.in[I_CW1]) + (size_t)li * 4096 * 128;
            const int r0 = part * 128 + half * 64;
            float s = 0.f;
            for (int q = 0; q < 64; ++q) s += pos[r0 + q] * w1[(size_t)(r0 + q) * 128 + col];
            pb[((size_t)li * 64 + part * 2 + half) * 128 + col] = s;
        }
    }
    {
        const int lane = TID() & 63, w = TID() >> 6, r = lane & 31, h = lane >> 5;
        for (int it = BID(); it < 2 * 16 * 16; it += GDIM()) {
            const int dblk = it & 15, hp = (it >> 4) & 15, L = it >> 8;
            const float* wq = lnd(p.in[I_PWQ]) + (size_t)L * 2048 * 2048;
            const float* sk = lnd(p.in[I_PSK]) + ((size_t)L * 16 + hp) * 128 * 128;
            u16* wpt = (u16*)(ws + WS_WT) + (size_t)L * WT_LAYER + WT_WP;
            const int d = dblk * 128 + w * 32 + r;
            f32x16 acc[4];
#pragma unroll
            for (int nb = 0; nb < 4; ++nb) acc[nb] = zero16();
#pragma unroll 1
            for (int ks = 0; ks < 8; ++ks) {
                const float* apx = wq + (size_t)d * 2048 + hp * 128 + ks * 16 + h * 8;
                float4 a0 = *(const float4*)apx, a1 = *(const float4*)(apx + 4);
                float av[8] = {a0.x, a0.y, a0.z, a0.w, a1.x, a1.y, a1.z, a1.w};
                float ahf[8], alf[8];
#pragma unroll
                for (int q = 0; q < 8; ++q) { ahf[q] = __uint_as_float((unsigned)f2bf(av[q]) << 16); alf[q] = av[q] - ahf[q]; }
                bf16x8 ah = pack8(ahf[0], ahf[1], ahf[2], ahf[3], ahf[4], ahf[5], ahf[6], ahf[7]);
                bf16x8 al = pack8(alf[0], alf[1], alf[2], alf[3], alf[4], alf[5], alf[6], alf[7]);
#pragma unroll
                for (int nb = 0; nb < 4; ++nb) {
                    const float* bpx = sk + (size_t)(nb * 32 + r) * 128 + ks * 16 + h * 8;
                    float4 b0 = *(const float4*)bpx, b1 = *(const float4*)(bpx + 4);
                    float bv[8] = {b0.x, b0.y, b0.z, b0.w, b1.x, b1.y, b1.z, b1.w};
                    float bhf[8], blf[8];
#pragma unroll
                    for (int q = 0; q < 8; ++q) { bhf[q] = __uint_as_float((unsigned)f2bf(bv[q]) << 16); blf[q] = bv[q] - bhf[q]; }
                    bf16x8 bh = pack8(bhf[0], bhf[1], bhf[2], bhf[3], bhf[4], bhf[5], bhf[6], bhf[7]);
                    bf16x8 bl = pack8(blf[0], blf[1], blf[2], blf[3], blf[4], blf[5], blf[6], blf[7]);
                    acc[nb] = MFMA(ah, bh, acc[nb]);
                    acc[nb] = MFMA(ah, bl, acc[nb]);
                    acc[nb] = MFMA(al, bh, acc[nb]);
                }
            }
#pragma unroll
            for (int nb = 0; nb < 4; ++nb)
#pragma unroll
                for (int a = 0; a < 4; ++a) {
                    u32x2 v; v[0] = pk2(acc[nb][4 * a], acc[nb][4 * a + 1]); v[1] = pk2(acc[nb][4 * a + 2], acc[nb][4 * a + 3]);
                    *(u32x2*)&wpt[(size_t)(hp * 128 + nb * 32 + r) * 2048 + dblk * 128 + w * 32 + 8 * a + 4 * h] = v;
                }
        }
    }
}

#define XB_TMO      128
#define XB_XCNT(j)  (256  + 64 * (j))
#define XB_XSUB(j)  (1280 + 64 * (j))
#define XB_XGEN(j)  (2304 + 64 * (j))
#define XB_TOP      3328
#define XB_TOPGEN   3392
#define XCD_BAR_WORDS 3456
#define XB_SPIN_CAP (1u << 18)
#define LAS __attribute__((address_space(3)))

__device__ __forceinline__ unsigned* xb_va(unsigned* p) { unsigned z = 0; asm volatile("" : "+v"(z)); return (unsigned*)((char*)p + (size_t)z); }
__device__ __forceinline__ unsigned xb_ld(unsigned* p)              { return __hip_atomic_load(xb_va(p), __ATOMIC_RELAXED, __HIP_MEMORY_SCOPE_AGENT); }
__device__ __forceinline__ unsigned xb_add(unsigned* p, unsigned v) { return __hip_atomic_fetch_add(xb_va(p), v, __ATOMIC_RELAXED, __HIP_MEMORY_SCOPE_AGENT); }
__device__ __forceinline__ unsigned xb_xcc_id() { return (unsigned)__builtin_amdgcn_s_getreg((3 << 11) | 20) & 0xFu; }
#define XB_SPIN(cond, bar) do { unsigned _sp = 0; while (cond) { __builtin_amdgcn_s_sleep(1); \
    if ((++_sp & 255u) == 0u) { if (xb_ld(&(bar)[XB_TMO])) break; if (_sp > XB_SPIN_CAP) { atomicAdd(&(bar)[XB_TMO], 1u); break; } } } } while (0)

struct XcdBarrier {
    unsigned* bar; unsigned x;
    volatile LAS unsigned* st;
};

__device__ __forceinline__ XcdBarrier xcd_barrier_post(unsigned* bar, volatile LAS unsigned* st) {
    XcdBarrier b; b.bar = bar; b.x = xb_xcc_id(); b.st = st;
    if (threadIdx.x == 0) (void)xb_add(&bar[XB_XCNT(b.x)], 1u);
    return b;
}
__device__ __forceinline__ void xcd_barrier_complete(unsigned* bar, unsigned x, unsigned& nloc, unsigned& nx) {
    const unsigned G = gridDim.x * gridDim.y * gridDim.z;
    unsigned sum, cnt, mine, sp = 0u;
    for (;;) {
        sum = 0u; cnt = 0u; mine = 0u;
#pragma unroll
        for (unsigned j = 0; j < 16; ++j) { const unsigned c = xb_ld(&bar[XB_XCNT(j)]); sum += c; cnt += (c > 0u) ? 1u : 0u; mine = (j == x) ? c : mine; }
        if (sum == G) break;
        __builtin_amdgcn_s_sleep(1);
        if ((++sp & 255u) == 0u) { if (xb_ld(&bar[XB_TMO])) break; if (sp > XB_SPIN_CAP) { atomicAdd(&bar[XB_TMO], 1u); break; } }
    }
    nloc = mine > 0u ? mine : 1u; nx = cnt > 0u ? cnt : 1u;
}

__device__ __forceinline__ void xcd_barrier(const XcdBarrier& b) {
    asm volatile("s_waitcnt vmcnt(0)" ::: "memory");
    __syncthreads();
    if (threadIdx.x == 0) {
        unsigned* bar = b.bar;
        const unsigned bx = xb_xcc_id();
        __builtin_amdgcn_s_waitcnt(0);
        unsigned nloc = b.st[0], nx = b.st[1];
        if (nloc == 0u) { xcd_barrier_complete(bar, bx, nloc, nx); b.st[0] = nloc; b.st[1] = nx; }
        const unsigned old = xb_add(&bar[XB_XSUB(bx)], 1u);
        const unsigned gen = old / nloc;
        if (old + 1u == (gen + 1u) * nloc) {
            __builtin_amdgcn_fence(__ATOMIC_RELEASE, "agent");
            asm volatile("s_waitcnt vmcnt(0)" ::: "memory");
            const unsigned og = xb_add(&bar[XB_TOP], 1u);
            const unsigned tg = og / nx;
            if (og + 1u == (tg + 1u) * nx) xb_add(&bar[XB_TOPGEN], 1u);
            else XB_SPIN(xb_ld(&bar[XB_TOPGEN]) == tg, bar);
            __builtin_amdgcn_fence(__ATOMIC_ACQUIRE, "agent");
            xb_add(&bar[XB_XGEN(bx)], 1u);
            asm volatile("s_waitcnt vmcnt(0)" ::: "memory");
        } else {
            XB_SPIN(xb_ld(&bar[XB_XGEN(bx)]) == gen, bar);
            __builtin_amdgcn_fence(__ATOMIC_ACQUIRE, "agent");
            asm volatile("s_waitcnt vmcnt(0)" ::: "memory");
        }
    }
    __syncthreads();
}


#ifndef REP_MASK
#define REP_MASK 0
#endif
#ifndef TOPK_REP
#define TOPK_REP 1
#endif
enum { K_GEMM = 0, K_ATTN0, K_ATTN1, K_RETSTATE, K_CMP, K_RETOUT, K_XATTN, K_CMPFIN, K_RETSCAN };

DI void make_desc(const P& p, int L, int ph, int it, const float* xres, GT& g) {
    size_t wsoff_ = 0; asm volatile("" : "+s"(wsoff_)); char* ws = p.ws + wsoff_;
    g.aux = nullptr; g.dst = nullptr; g.amode = 0; g.kbeg = 0; g.ncols = 128; g.e0 = 0; g.e1 = 0;
    if (ph == 0) {
        if (it < 53 * 32) { inproj_desc(p, L, it >> 5, it & 31, g); }
        else {
            int q = it - 53 * 32; int which = q >> 6; int nt = (q >> 2) & 15, mt = q & 3;
            g.A = (const u16*)(ws + WS_MEMB); g.lda = 2048; g.M = 1024; g.m0 = mt * 256; g.ldb = 2048; g.K = 2048;
            g.B = (const u16*)(ws + WS_WT) + (size_t)L * WT_LAYER + (which ? WT_XV : WT_XK) + (size_t)(nt * 128) * 2048;
            if (which == 0) { g.emode = E_PLAIN; g.dst = ws + WS_XK; g.e0 = 2048; g.e1 = nt * 128; }
            else { g.emode = E_XVT; g.dst = ws + WS_XVT; g.e0 = 0; g.e1 = nt * 128; }
        }
    } else if (ph == 1) {
        const int mt = it & 3, ksp = (it >> 2) & 7, i = it >> 5;
        g.A = (const u16*)(ws + (i ? WS_VC : WS_KC)); g.lda = 0; g.amode = 1; g.kbeg = ksp * 512; g.M = 1024; g.m0 = mt * 256;
        g.B = (const u16*)(ws + WS_WT) + (size_t)L * WT_LAYER + WT_CW1 + (size_t)i * 128 * 4096 + ksp * 512; g.ldb = 4096; g.K = 512;
        g.emode = E_F32; g.e0 = 128; g.e1 = 0; g.dst = ws + WS_CPART + (size_t)(i * 8 + ksp) * 1024 * 128 * 4;
    } else {
        const int nt = it >> 5, mt = it & 31;
        g.lda = 2048; g.M = T; g.m0 = mt * 256; g.ldb = 2048; g.K = 2048; g.e1 = nt * 128;
        const u16* wt = (const u16*)(ws + WS_WT) + (size_t)L * WT_LAYER;
        if (ph == 5) { g.A = (const u16*)(ws + WS_MIX); g.B = wt + WT_OUT + (size_t)(nt * 128) * 2048; g.emode = E_RESID; g.aux = xres; }
        else if (ph == 7) { g.A = (const u16*)(ws + WS_XB); g.B = wt + WT_XQ + (size_t)(nt * 128) * 2048; g.emode = E_PLAIN; g.e0 = 2048; g.dst = ws + WS_XQ; }
        else if (ph == 9) { g.A = (const u16*)(ws + WS_XO); g.B = wt + WT_XO + (size_t)(nt * 128) * 2048; g.emode = E_RESID; g.aux = (const float*)(ws + WS_XF); }
        else { g.A = (const u16*)(ws + WS_XB); g.B = wt + WT_WP + (size_t)(nt * 128) * 2048; g.emode = E_F32; g.e0 = 2048; g.dst = ws + WS_SCORES; }
    }
}

__global__ void __launch_bounds__(256, 2) mega(P p) {
    cg::grid_group grid = cg::this_grid();
    __shared__ __attribute__((aligned(16))) char smem[61440];
    size_t wsoff_ = 0; asm volatile("" : "+s"(wsoff_)); char* ws = p.ws + wsoff_;
    const int G = GDIM(), bid = BID();

    __shared__ uint4 xb_words;
    unsigned* barw = (unsigned*)(ws + WS_BAR);
    if (threadIdx.x == 0) xb_words = make_uint4(0u, 0u, 0u, 0u);
    __syncthreads();
    XcdBarrier xb = xcd_barrier_post(barw, (volatile LAS unsigned*)&xb_words);
    if (p.ws == nullptr) grid.sync();
    for (int rep = 0; rep < 1 + ((REP_MASK >> 13) & 1); ++rep) prep_phase(p, smem);
    xcd_barrier(xb);

#pragma unroll 1
    for (int L = 0; L < 2; ++L) {
        const float* xres = (L == 0) ? lnd(p.in[I_X]) : (const float*)(ws + WS_XF);
#pragma unroll 1
        for (int ph = 0; ph < 13; ++ph) {
#pragma unroll 1
            for (int rep = 0; rep < 1 + ((REP_MASK >> ph) & 1); ++rep)
            if (ph == 6 || ph == 10) {
                const int gi = (ph == 6) ? I_LN1G : I_LN2G;
                ln_phase(p, lnd(p.in[gi]) + L * 2048, lnd(p.in[gi + 1]) + L * 2048);
            } else if (ph == 12) {
                peer_phase(p, L, smem, (rep < ((REP_MASK >> 12) & 1)) ? (float*)(ws + WS_Y) : (L == 1) ? p.out : (float*)(ws + WS_XF));
            } else {
                int n = 512;
                if (ph == 0) n = 53 * 32 + 128; else if (ph == 1) n = 64 + 512 + 512; else if (ph == 2) n = 256 + 512; else if (ph == 3) n = 1024;
#pragma unroll 1
                for (int it = bid; it < n; it += G) {
                    int kind = K_GEMM, sub = it;
                    if (ph == 1) { if (it >= 576) { kind = K_RETSTATE; sub = it - 576; } else if (it >= 64) { kind = K_ATTN0; sub = it - 64; } }
                    else if (ph == 2) { if (it < 256) kind = K_CMPFIN; else { kind = K_RETSCAN; sub = it - 256; } }
                    else if (ph == 3) { if (it < 512) kind = K_CMP; else { kind = K_RETOUT; sub = it - 512; } }
                    else if (ph == 4) { kind = K_ATTN1; if (it >= 256) sub = it ^ 63; }
                    else if (ph == 8) kind = K_XATTN;
                    switch (kind) {
                    case K_GEMM: { GT g; make_desc(p, L, ph, sub, xres, g); gemm_tile(p, L, smem, g); } break;
                    case K_ATTN0: attn_item<0>(p, sub, smem); break;
                    case K_ATTN1: attn_item<1>(p, sub, smem); break;
                    case K_RETSTATE: retstate_item(p, sub); break;
                    case K_CMP: cmp_item(p, sub, smem); break;
                    case K_RETOUT: retout_item(p, L, sub, smem); break;
                    case K_XATTN: xattn_item(p, sub, smem); break;
                    case K_CMPFIN: cmpfin_item(p, L, sub, smem); break;
                    case K_RETSCAN: retscan_item(p, sub); break;
                    }
                }
            }
            { size_t bo = 0; asm volatile("" : "+s"(bo)); xb.bar = (unsigned*)(p.ws + bo + WS_BAR); }
            xcd_barrier(xb);
        }
    }
}

extern "C" void kernel_launch(void* const* d_in, const int* in_sizes, int n_in, void* d_out, int out_size, void* d_ws, size_t ws_size,
                              hipStream_t stream) {
    static int grid_blocks = 0;
    if (!grid_blocks) {
        int dev = 0, cus = 0, per_cu = 0;
        (void)hipGetDevice(&dev);
        (void)hipDeviceGetAttribute(&cus, hipDeviceAttributeMultiprocessorCount, dev);
        (void)hipOccupancyMaxActiveBlocksPerMultiprocessor(&per_cu, mega, 256, 0);
        if (per_cu > 2) per_cu = 2;
        if (per_cu < 1) per_cu = 1;
        grid_blocks = cus * per_cu;
        if (ws_size < WS_END) fprintf(stderr, "kernel_launch: workspace too small: %zu < %zu\n", ws_size, (size_t)WS_END);
    }
    P p{};
    for (int i = 0; i < 24; ++i) p.in[i] = (const float*)d_in[i];
    p.out = (float*)d_out;
    p.ws = (char*)d_ws;
    void* args[] = {&p};
    if (hipMemsetAsync((char*)d_ws + WS_BAR, 0, XCD_BAR_WORDS * sizeof(unsigned), stream) != hipSuccess) { fprintf(stderr, "kernel_launch: memset of the barrier words failed\n"); return; }
    hipError_t e = hipLaunchCooperativeKernel((void*)mega, dim3(grid_blocks), dim3(256), args, 0, stream);
    if (e != hipSuccess) fprintf(stderr, "cooperative launch failed: %s (grid %d)\n", hipGetErrorString(e), grid_blocks);
}
```

```cpp
#include <hip/hip_runtime.h>
#include <hip/hip_cooperative_groups.h>
#include <cstdio>
namespace cg = cooperative_groups;
#ifndef TOPK_REP
#define TOPK_REP 1
#endif

#define DI __device__ __forceinline__
typedef unsigned short u16;
using bf16x8 = __attribute__((ext_vector_type(8))) short;
using f32x16 = __attribute__((ext_vector_type(16))) float;
using u32x4 = __attribute__((ext_vector_type(4))) unsigned;
using u32x2 = __attribute__((ext_vector_type(2))) unsigned;
using u32x6 = __attribute__((ext_vector_type(6))) unsigned;
using f32x16v = __attribute__((ext_vector_type(16))) float;
using f32x32 = __attribute__((ext_vector_type(32))) float;
#define MFMA(a, b, c) __builtin_amdgcn_mfma_f32_32x32x16_bf16((a), (b), (c), 0, 0, 0)

static constexpr int T = 8192, D = 2048, S = 2048, NB = 4, PIN = 6680;
static constexpr float ALPHA = 1.4142135623730951f;
static constexpr float SC128 = 0.08838834764831845f;
static constexpr float SC512 = 0.04419417382415922f;
static constexpr float NEG = -1e30f;

enum { I_X = 0, I_MEM, I_WIN, I_BGATE, I_CPOS, I_CW1, I_CW2, I_GNG, I_GNB, I_WOUT, I_LN1G, I_LN1B, I_XWQ, I_XWK, I_XWV, I_XWO,
       I_LN2G, I_LN2B, I_PWQ, I_PSK, I_PU, I_PV, I_LN3G, I_LN3B };

static constexpr size_t MB = 1ull << 20;
static constexpr size_t WS_XB = 0;
static constexpr size_t WS_XF = WS_XB + 32 * MB;
static constexpr size_t WS_Y = WS_XF + 64 * MB;
static constexpr size_t WS_MEMB = WS_Y + 64 * MB;
static constexpr size_t WS_ROPE = WS_MEMB + 4 * MB;
static constexpr size_t WS_QN = WS_ROPE + 1 * MB;
static constexpr size_t WS_QR = WS_QN + 16 * MB;
static constexpr size_t WS_KC = WS_QR + 16 * MB;
static constexpr size_t WS_VC = WS_KC + 4 * MB;
static constexpr size_t WS_KS = WS_VC + 4 * MB;
static constexpr size_t WS_VST = WS_KS + 4 * MB;
static constexpr size_t WS_KW = WS_VST + 4 * MB;
static constexpr size_t WS_VWT = WS_KW + 4 * MB;
static constexpr size_t WS_GATES = WS_VWT + 4 * MB;
static constexpr size_t WS_RQ = WS_GATES + 1 * MB;
static constexpr size_t WS_RK = WS_RQ + 16 * MB;
static constexpr size_t WS_RKZT = WS_RK + 16 * MB;
static constexpr size_t WS_RVT = WS_RKZT + 16 * MB;
static constexpr size_t WS_RGS = WS_RVT + 16 * MB;
static constexpr size_t WS_XK = WS_RGS + 16 * MB;
static constexpr size_t WS_XVT = WS_XK + 4 * MB;
static constexpr size_t WS_CPART = WS_XVT + 4 * MB;
static constexpr size_t WS_KCMP = WS_CPART + 8 * MB;
static constexpr size_t WS_VCMPT = WS_KCMP + 1 * MB;
static constexpr size_t WS_POSB = WS_VCMPT + 1 * MB;
static constexpr size_t WS_WT = WS_POSB + 1 * MB;
static constexpr size_t WS_SST = WS_WT + 162 * MB;
static constexpr size_t WS_ONSA = WS_SST + 32 * MB;
static constexpr size_t WS_MIX = WS_ONSA + 32 * MB;
static constexpr size_t WS_SEL = WS_MIX + 32 * MB;
static constexpr size_t WS_XQ = WS_SEL + 1 * MB;
static constexpr size_t WS_XO = WS_XQ + 32 * MB;
static constexpr size_t WS_SCORES = WS_XO + 32 * MB;
static constexpr size_t WS_UB = WS_SCORES + 64 * MB;
static constexpr size_t WS_VB = WS_UB + 64 * MB;
static constexpr size_t WS_RBUF = WS_VB + 64 * MB;
static constexpr size_t WS_OC = WS_RBUF + 16 * MB;
static constexpr size_t WS_BAR = WS_OC + 32 * MB;
static constexpr size_t WS_END = WS_BAR + 1 * MB;

static constexpr size_t WT_IN = 0;
static constexpr size_t WT_OUT = (size_t)6784 * 2048;
static constexpr size_t WT_XQ = WT_OUT + (size_t)2048 * 2048;
static constexpr size_t WT_XK = WT_XQ + (size_t)2048 * 2048;
static constexpr size_t WT_XV = WT_XK + (size_t)2048 * 2048;
static constexpr size_t WT_XO = WT_XV + (size_t)2048 * 2048;
static constexpr size_t WT_WP = WT_XO + (size_t)2048 * 2048;
static constexpr size_t WT_CW1 = WT_WP + (size_t)2048 * 2048;
static constexpr size_t WT_LAYER = WT_CW1 + (size_t)2 * 128 * 4096;
static_assert(2 * WT_LAYER * 2 <= 162 * MB, "WT region");

struct P {
    const float* in[24];
    float* out;
    char* ws;
};

typedef float f32x2_t __attribute__((ext_vector_type(2)));
typedef __bf16 bf16x2_t __attribute__((ext_vector_type(2)));
DI unsigned pk2(float a, float b) { f32x2_t v = {a, b}; return __builtin_bit_cast(unsigned, __builtin_convertvector(v, bf16x2_t)); }
DI u16 f2bf(float x) { return (u16)(pk2(x, x) & 0xffffu); }
DI float bflo(unsigned v) { return __uint_as_float(v << 16); }
DI float bfhi(unsigned v) { return __uint_as_float(v & 0xffff0000u); }
DI const float* lnd(const float* q) { size_t o = 0; asm volatile("" : "+s"(o)); return q + o; }
DI int TID() { int t = threadIdx.x; asm volatile("" : "+v"(t)); return t; }
DI int BID() { int t = blockIdx.x; asm volatile("" : "+s"(t)); return t; }
DI int GDIM() { int t = gridDim.x; asm volatile("" : "+s"(t)); return t; }
DI int crow(int i, int h) { return (i & 3) + 8 * (i >> 2) + 4 * h; }
DI bf16x8 ldfrag(const u16* p) { return *(const bf16x8*)p; }
DI bf16x8 ld2x8(const u16* p0, const u16* p1) {
    u32x2 a = *(const u32x2*)p0; u32x2 b = *(const u32x2*)p1; u32x4 v = {a[0], a[1], b[0], b[1]};
    return __builtin_bit_cast(bf16x8, v);
}
DI bf16x8 pack8(float a0, float a1, float a2, float a3, float a4, float a5, float a6, float a7) {
    u32x4 v = {pk2(a0, a1), pk2(a2, a3), pk2(a4, a5), pk2(a6, a7)};
    return __builtin_bit_cast(bf16x8, v);
}
DI f32x16 zero16() { f32x16 z; for (int i = 0; i < 16; ++i) z[i] = 0.f; return z; }
DI float gelu_erf(float x) { return 0.5f * x * (1.f + erff(x * 0.7071067811865476f)); }
DI float wave_sum(float v) { for (int o = 32; o >= 1; o >>= 1) v += __shfl_xor(v, o); return v; }
#define CBAR() __asm__ volatile("" ::: "memory")

enum { E_QDUAL = 0, E_PLAIN, E_ROPE, E_VT, E_RK, E_GATE, E_SILU, E_XVT, E_RESID, E_F32 };
struct GT {
    const u16* A; int lda; int amode; int M; int m0; int kbeg;
    const u16* B; int ldb; int ncols; int K;
    int emode; int e0; int e1;
    void* dst; const float* aux;
};

DI void gemm_tile(const P& p, int L, char* smem, const GT& g) {
    u16* As = (u16*)smem;
    u16* Bs = (u16*)(smem + 36864);
    const int tid = TID(), lane = tid & 63, w = tid >> 6, r = lane & 31, h = lane >> 5;
    const int trow = tid >> 3, tkc = tid & 7;
    unsigned voffa, voffb;
    size_t astep;
    const u16* abase;
    if (g.amode == 0) { voffa = (unsigned)(trow * g.lda + tkc * 8) * 2u; astep = (size_t)32 * g.lda; abase = g.A + (size_t)g.m0 * g.lda; }
    else { voffa = (unsigned)((trow >> 1) * 4096 + (trow & 1) * 128 + tkc * 8) * 2u; astep = 65536; abase = g.A + (size_t)(g.m0 >> 8) * 2048 * 256; }
    voffb = (unsigned)(trow * g.ldb + tkc * 8) * 2u;
    const size_t bstep = (size_t)32 * g.ldb;
    const int brows = (g.ncols + 31) >> 5;
    f32x16 acc[2][4];
#pragma unroll
    for (int a = 0; a < 2; ++a)
#pragma unroll
        for (int b = 0; b < 4; ++b) acc[a][b] = zero16();
    u32x4 pa[8], pb[4];
#define GLOAD(k0_) do { const int k0 = (k0_); const int koff = g.amode ? (((k0 + g.kbeg) >> 7) * 256 + ((k0 + g.kbeg) & 127)) : k0; \
        _Pragma("unroll") for (int i = 0; i < 8; ++i) pa[i] = *(const u32x4*)((const char*)(abase + (size_t)i * astep + koff) + voffa); \
        _Pragma("unroll") for (int i = 0; i < 4; ++i) pb[i] = *(const u32x4*)((const char*)(g.B + (size_t)(i < brows ? i : 0) * bstep + k0) + voffb); } while (0)
#define SSTORE() do { \
        _Pragma("unroll") for (int i = 0; i < 8; ++i) *(u32x4*)&As[((tid >> 3) + 32 * i) * 72 + (tid & 7) * 8] = pa[i]; \
        _Pragma("unroll") for (int i = 0; i < 4; ++i) *(u32x4*)&Bs[((tid >> 3) + 32 * i) * 72 + (tid & 7) * 8] = pb[i]; } while (0)
#define RDA(ks_) do { fa[ks_][0] = *(const bf16x8*)(arp + (ks_) * 16); fa[ks_][1] = *(const bf16x8*)(arp + 32 * 72 + (ks_) * 16); } while (0)
#define RDB(ks_, nb_) fb[ks_][nb_] = *(const bf16x8*)(brp + (nb_) * 32 * 72 + (ks_) * 16)
#define MM(ks_, nb_) do { acc[0][nb_] = MFMA(fa[ks_][0], fb[ks_][nb_], acc[0][nb_]); acc[1][nb_] = MFMA(fa[ks_][1], fb[ks_][nb_], acc[1][nb_]); } while (0)
#define SB() __builtin_amdgcn_sched_barrier(0)
#define COMPUTE() do { bf16x8 fa[4][2], fb[4][4]; const u16* arp = &As[(w * 64 + r) * 72 + h * 8]; const u16* brp = &Bs[r * 72 + h * 8]; \
        RDA(0); RDB(0, 0); RDB(0, 1); SB(); \
        RDB(0, 2); SB(); MM(0, 0); SB(); \
        RDB(0, 3); SB(); MM(0, 1); SB(); \
        RDA(1); RDB(1, 0); SB(); MM(0, 2); SB(); \
        RDB(1, 1); SB(); MM(0, 3); SB(); \
        RDB(1, 2); SB(); MM(1, 0); SB(); \
        RDB(1, 3); SB(); MM(1, 1); SB(); \
        RDA(2); RDB(2, 0); SB(); MM(1, 2); SB(); \
        RDB(2, 1); SB(); MM(1, 3); SB(); \
        RDB(2, 2); SB(); MM(2, 0); SB(); \
        RDB(2, 3); SB(); MM(2, 1); SB(); \
        RDA(3); RDB(3, 0); SB(); MM(2, 2); SB(); \
        RDB(3, 1); SB(); MM(2, 3); SB(); \
        RDB(3, 2); SB(); MM(3, 0); SB(); \
        RDB(3, 3); SB(); MM(3, 1); SB(); \
        SB(); MM(3, 2); SB(); \
        SB(); MM(3, 3); SB(); } while (0)
    const int nk = g.K >> 6;
    GLOAD(0);
    __syncthreads();
    SSTORE();
    __syncthreads();
#pragma unroll 1
    for (int kt = 0; kt < nk; ++kt) {
        if (kt + 1 < nk) GLOAD((kt + 1) << 6);
        COMPUTE();
        __syncthreads();
        if (kt + 1 < nk) { SSTORE(); __syncthreads(); }
    }
#undef GLOAD
#undef SSTORE
#undef COMPUTE
#undef RDA
#undef RDB
#undef MM
#undef SB
    size_t wsoff_ = 0; asm volatile("" : "+s"(wsoff_)); char* ws = p.ws + wsoff_;
    const int rbase = g.m0 + w * 64;
    switch (g.emode) {
    case E_QDUAL: case E_ROPE: case E_RK: {
        const float2* tab = (const float2*)(ws + WS_ROPE);
        const float sc = (g.emode == E_RK) ? SC128 : 1.f;
        u16* dst = (u16*)g.dst;
        const int ld = g.e0, co = g.e1;
        float log2g = 0.f;
        if (g.emode == E_RK) log2g = log2f(1.f - exp2f(-5.f - (float)(co >> 7)));
        u16* dT = (u16*)(ws + WS_RKZT); const int head = co >> 7;
        u16* qn = (u16*)(ws + WS_QN);
#pragma unroll
        for (int mb = 0; mb < 2; ++mb)
#pragma unroll
            for (int a = 0; a < 4; ++a) {
                const int row0 = rbase + mb * 32 + 8 * a + 4 * h; const int b = row0 >> 11, s0 = row0 & 2047;
                float z[4] = {1.f, 1.f, 1.f, 1.f};
                if (g.emode == E_RK) {
#pragma unroll
                    for (int c = 0; c < 4; ++c) z[c] = exp2f((float)(127 - ((s0 + c) & 127)) * log2g);
                }
#pragma unroll
                for (int nb = 0; nb < 2; ++nb) {
                    const int d = nb * 32 + r;
                    float o1[4], o2[4];
#pragma unroll
                    for (int c = 0; c < 4; ++c) {
                        const int i = 4 * a + c; const int row = row0 + c;
                        float2 cs = tab[(s0 + c) * 64 + d];
                        float x1 = acc[mb][nb][i], x2 = acc[mb][nb + 2][i];
                        o1[c] = (x1 * cs.x - x2 * cs.y) * sc; o2[c] = (x1 * cs.y + x2 * cs.x) * sc;
                        if (g.emode == E_QDUAL) { qn[(size_t)row * ld + co + d] = f2bf(x1); qn[(size_t)row * ld + co + d + 64] = f2bf(x2); }
                        dst[(size_t)row * ld + co + d] = f2bf(o1[c]); dst[(size_t)row * ld + co + d + 64] = f2bf(o2[c]);
                    }
                    if (g.emode == E_RK) {
                        u32x2 v; v[0] = pk2(o1[0] * z[0], o1[1] * z[1]); v[1] = pk2(o1[2] * z[2], o1[3] * z[3]);
                        *(u32x2*)&dT[((size_t)(b * 8 + head) * 128 + d) * 2048 + s0] = v;
                        v[0] = pk2(o2[0] * z[0], o2[1] * z[1]); v[1] = pk2(o2[2] * z[2], o2[3] * z[3]);
                        *(u32x2*)&dT[((size_t)(b * 8 + head) * 128 + d + 64) * 2048 + s0] = v;
                    }
                }
                __builtin_amdgcn_sched_barrier(0);
            }
    } break;
    case E_PLAIN: case E_SILU: {
        u16* dst = (u16*)g.dst; const int ld = g.e0, co = g.e1;
#pragma unroll
        for (int mb = 0; mb < 2; ++mb)
#pragma unroll
            for (int i = 0; i < 16; ++i) {
                const int row = rbase + mb * 32 + crow(i, h);
                if (row < g.M) {
#pragma unroll
                    for (int nb = 0; nb < 4; ++nb) {
                        float v = acc[mb][nb][i];
                        if (g.emode == E_SILU) v = v / (1.f + __expf(-v));
                        dst[(size_t)row * ld + co + nb * 32 + r] = f2bf(v);
                    }
                }
            }
    } break;
    case E_VT: {
        u16* dT = (u16*)g.dst; const int nh = g.e0, head = g.e1;
#pragma unroll
        for (int mb = 0; mb < 2; ++mb)
#pragma unroll
            for (int a = 0; a < 4; ++a) {
                const int row0 = rbase + mb * 32 + 8 * a + 4 * h; const int b = row0 >> 11, s0 = row0 & 2047;
#pragma unroll
                for (int nb = 0; nb < 4; ++nb) {
                    const int d = nb * 32 + r;
                    u32x2 v; v[0] = pk2(acc[mb][nb][4 * a], acc[mb][nb][4 * a + 1]); v[1] = pk2(acc[mb][nb][4 * a + 2], acc[mb][nb][4 * a + 3]);
                    *(u32x2*)&dT[((size_t)(b * nh + head) * 128 + d) * 2048 + s0] = v;
                }
            }
    } break;
    case E_XVT: {
        u16* dT = (u16*)g.dst; const int head = g.e1 >> 9, d0 = g.e1 & 511;
#pragma unroll
        for (int mb = 0; mb < 2; ++mb)
#pragma unroll
            for (int a = 0; a < 4; ++a) {
                const int row0 = rbase + mb * 32 + 8 * a + 4 * h; const int b = row0 >> 8, m = row0 & 255;
#pragma unroll
                for (int nb = 0; nb < 4; ++nb) {
                    const int d = d0 + nb * 32 + r;
                    u32x2 v; v[0] = pk2(acc[mb][nb][4 * a], acc[mb][nb][4 * a + 1]); v[1] = pk2(acc[mb][nb][4 * a + 2], acc[mb][nb][4 * a + 3]);
                    *(u32x2*)&dT[((size_t)(b * 4 + head) * 512 + d) * 256 + m] = v;
                }
            }
    } break;
    case E_GATE: {
        float* dst = (float*)(ws + WS_GATES); const float* bg = lnd(p.in[I_BGATE]) + L * 24;
        if (r < 24) {
            const float bias = bg[r];
#pragma unroll
            for (int mb = 0; mb < 2; ++mb)
#pragma unroll
                for (int i = 0; i < 16; ++i) {
                    const int row = rbase + mb * 32 + crow(i, h);
                    float v = acc[mb][0][i] + bias;
                    dst[(size_t)row * 24 + r] = 1.f / (1.f + __expf(-v));
                }
        }
    } break;
    case E_RESID: {
        float* y = (float*)(ws + WS_Y); const float* xr = g.aux; const int co = g.e1;
#pragma unroll
        for (int mb = 0; mb < 2; ++mb)
#pragma unroll
            for (int i = 0; i < 16; ++i) {
                const int row = rbase + mb * 32 + crow(i, h);
#pragma unroll
                for (int nb = 0; nb < 4; ++nb) { size_t ix = (size_t)row * 2048 + co + nb * 32 + r; y[ix] = ALPHA * xr[ix] + acc[mb][nb][i]; }
            }
    } break;
    case E_F32: {
        float* dst = (float*)g.dst; const int ld = g.e0, co = g.e1;
#pragma unroll
        for (int mb = 0; mb < 2; ++mb)
#pragma unroll
            for (int i = 0; i < 16; ++i) {
                const int row = rbase + mb * 32 + crow(i, h);
#pragma unroll
                for (int nb = 0; nb < 4; ++nb) dst[(size_t)row * ld + co + nb * 32 + r] = acc[mb][nb][i];
            }
    } break;
    }
}

DI void inproj_desc(const P& p, int L, int nt, int mt, GT& g) {
    size_t wsoff_ = 0; asm volatile("" : "+s"(wsoff_)); char* ws = p.ws + wsoff_;
    g.A = (const u16*)(ws + WS_XB); g.lda = 2048; g.amode = 0; g.kbeg = 0; g.M = T; g.m0 = mt * 256; g.ldb = 2048; g.K = 2048; g.ncols = 128; g.aux = nullptr;
    const u16* W = (const u16*)(ws + WS_WT) + (size_t)L * WT_LAYER + WT_IN;
    int col0;
    if (nt < 8) { col0 = nt * 128; g.emode = E_QDUAL; g.dst = ws + WS_QR; g.e0 = 1024; g.e1 = nt * 128; }
    else if (nt < 10) { int q = nt - 8; col0 = 1024 + q * 128; g.emode = E_PLAIN; g.dst = ws + WS_KC; g.e0 = 256; g.e1 = q * 128; }
    else if (nt < 12) { int q = nt - 10; col0 = 1280 + q * 128; g.emode = E_PLAIN; g.dst = ws + WS_VC; g.e0 = 256; g.e1 = q * 128; }
    else if (nt < 14) { int q = nt - 12; col0 = 1536 + q * 128; g.emode = E_ROPE; g.dst = ws + WS_KS; g.e0 = 256; g.e1 = q * 128; }
    else if (nt < 16) { int q = nt - 14; col0 = 1792 + q * 128; g.emode = E_VT; g.dst = ws + WS_VST; g.e0 = 2; g.e1 = q; }
    else if (nt < 18) { int q = nt - 16; col0 = 2048 + q * 128; g.emode = E_ROPE; g.dst = ws + WS_KW; g.e0 = 256; g.e1 = q * 128; }
    else if (nt < 20) { int q = nt - 18; col0 = 2304 + q * 128; g.emode = E_VT; g.dst = ws + WS_VWT; g.e0 = 2; g.e1 = q; }
    else if (nt == 20) { col0 = 2560; g.emode = E_GATE; g.ncols = 24; g.dst = nullptr; g.e0 = 0; g.e1 = 0; }
    else if (nt < 29) { int q = nt - 21; col0 = 2584 + q * 128; g.emode = E_ROPE; g.dst = ws + WS_RQ; g.e0 = 1024; g.e1 = q * 128; }
    else if (nt < 37) { int q = nt - 29; col0 = 3608 + q * 128; g.emode = E_RK; g.dst = ws + WS_RK; g.e0 = 1024; g.e1 = q * 128; }
    else if (nt < 45) { int q = nt - 37; col0 = 4632 + q * 128; g.emode = E_VT; g.dst = ws + WS_RVT; g.e0 = 8; g.e1 = q; }
    else { int q = nt - 45; col0 = 5656 + q * 128; g.emode = E_SILU; g.dst = ws + WS_RGS; g.e0 = 1024; g.e1 = q * 128; }
    g.B = W + (size_t)col0 * 2048;
}

template <int MODE>
DI void attn_item(const P& p, int it, char* smem) {
    size_t wsoff_ = 0; asm volatile("" : "+s"(wsoff_)); char* ws = p.ws + wsoff_;
    const int lane = TID() & 63, w = TID() >> 6, r = lane & 31, h = lane >> 5;
    const int b = it >> 7, g = (it >> 6) & 1, qb = it & 63, q0 = qb * 32;
    const int hq = g * 4 + w;
    const u16* Q = (const u16*)(ws + WS_QR);
    const u16* K = (const u16*)(ws + (MODE == 0 ? WS_KW : WS_KS));
    const u16* VT = (const u16*)(ws + (MODE == 0 ? WS_VWT : WS_VST)) + (size_t)(b * 2 + g) * 128 * 2048;
    const int qpos = q0 + r;
    const size_t tq = (size_t)b * 2048 + qpos;
    bf16x8 qf[8];
#pragma unroll
    for (int ks = 0; ks < 8; ++ks) qf[ks] = ldfrag(Q + tq * 1024 + hq * 128 + ks * 16 + h * 8);
    unsigned selm = 0xffffffffu, um = 0xffffffffu;
    if (MODE == 1) {
        selm = ((const unsigned*)(ws + WS_SEL))[(size_t)(b * 2 + g) * 2048 + qpos];
        um = selm;
        for (int o = 1; o <= 16; o <<= 1) um |= __shfl_xor(um, o);
    }
    f32x16 o[4];
#pragma unroll
    for (int db = 0; db < 4; ++db) o[db] = zero16();
    float m = NEG, l = 0.f;
    unsigned tmask;
    {
        const int cur = q0 >> 6;
        const unsigned upto = (cur == 31) ? 0xffffffffu : ((1u << (cur + 1)) - 1u);
        if (MODE == 0) { int lo = q0 - 512; if (lo < 0) lo = 0; lo >>= 6; tmask = upto & ~((1u << lo) - 1u); }
        else tmask = (unsigned)__builtin_amdgcn_readfirstlane((int)um) & upto;
    }
    u16* Ks = (u16*)smem;
    u16* Vs = (u16*)(smem + 17408);
    const int tid = TID();
    const u16* Kg = K + ((size_t)b * 2048 + (tid >> 4)) * 256 + g * 128 + (tid & 15) * 8;
    const u16* Vg = VT + (size_t)(tid >> 3) * 2048 + (tid & 7) * 8;
    u32x4 kr0, kr1, kr2, kr3, vr0, vr1, vr2, vr3;
#define ALOAD(tile_) do { const u16* kq_ = Kg + (size_t)(tile_) * 64 * 256; const u16* vq_ = Vg + (tile_) * 64; \
        kr0 = *(const u32x4*)(kq_); kr1 = *(const u32x4*)(kq_ + 16 * 256); kr2 = *(const u32x4*)(kq_ + 32 * 256); kr3 = *(const u32x4*)(kq_ + 48 * 256); \
        vr0 = *(const u32x4*)(vq_); vr1 = *(const u32x4*)(vq_ + 32 * 2048); vr2 = *(const u32x4*)(vq_ + 64 * 2048); vr3 = *(const u32x4*)(vq_ + 96 * 2048); } while (0)
#define ASTORE() do { u16* kd_ = Ks + (tid >> 4) * 136 + (tid & 15) * 8; u16* vd_ = Vs + (tid >> 3) * 72 + (tid & 7) * 8; \
        *(u32x4*)(kd_) = kr0; *(u32x4*)(kd_ + 16 * 136) = kr1; *(u32x4*)(kd_ + 32 * 136) = kr2; *(u32x4*)(kd_ + 48 * 136) = kr3; \
        *(u32x4*)(vd_) = vr0; *(u32x4*)(vd_ + 32 * 72) = vr1; *(u32x4*)(vd_ + 64 * 72) = vr2; *(u32x4*)(vd_ + 96 * 72) = vr3; } while (0)
    int tile = __builtin_ctz(tmask); tmask &= tmask - 1u;
    ALOAD(tile);
    __syncthreads();
    ASTORE();
    __syncthreads();
    for (;;) {
        const bool more = tmask != 0u;
        const int ntile = more ? __builtin_ctz(tmask) : tile;
        tmask &= tmask - 1u;
        if (more) ALOAD(ntile);
        const bool full = (MODE == 0) ? ((tile * 64 + 63 <= q0) && ((q0 + 31) - tile * 64 < 512)) : (tile * 64 + 63 <= q0);
        const bool selbit = (MODE == 1) ? (((selm >> tile) & 1u) != 0u) : true;
#pragma unroll
        for (int sub = 0; sub < 2; ++sub) {
            const int kp0 = tile * 64 + sub * 32;
            if (kp0 > q0 + 31) continue;
            f32x16 s = zero16();
#pragma unroll
            for (int ks = 0; ks < 8; ++ks) s = MFMA(*(const bf16x8*)&Ks[(sub * 32 + r) * 136 + ks * 16 + h * 8], qf[ks], s);
            constexpr float C2 = 0.12751743074602467f;
            float pv[16];
            float mx = NEG;
            float ps = 0.f;
            float mn, corr;
            const float m_old = m;
            if (full) {
#pragma unroll
                for (int i = 0; i < 16; ++i) { const float t = s[i] * C2; pv[i] = t; mx = fmaxf(mx, t); }
                if (MODE == 1) mx = selbit ? mx : NEG;
                mx = fmaxf(mx, __shfl_xor(mx, 32));
                mn = fmaxf(m, mx);
                corr = __builtin_amdgcn_exp2f(m - mn);
#pragma unroll
                for (int i = 0; i < 16; ++i) { float e = __builtin_amdgcn_exp2f(pv[i] - mn); if (MODE == 1) e = selbit ? e : 0.f; pv[i] = e; ps += e; }
            } else {
                bool okv[16];
#pragma unroll
                for (int i = 0; i < 16; ++i) {
                    const int key = kp0 + crow(i, h);
                    bool ok = key <= qpos;
                    if (MODE == 0) ok = ok && (qpos - key < 512);
                    else ok = ok && selbit;
                    okv[i] = ok;
                    const float t = ok ? s[i] * C2 : NEG;
                    pv[i] = t; mx = fmaxf(mx, t);
                }
                mx = fmaxf(mx, __shfl_xor(mx, 32));
                mn = fmaxf(m, mx);
                corr = __builtin_amdgcn_exp2f(m - mn);
#pragma unroll
                for (int i = 0; i < 16; ++i) { float e = okv[i] ? __builtin_amdgcn_exp2f(pv[i] - mn) : 0.f; pv[i] = e; ps += e; }
            }
            l = l * corr + ps; m = mn;
            if (__builtin_amdgcn_ballot_w64(mn > m_old) != 0ull) {
#pragma unroll
                for (int db = 0; db < 4; ++db)
#pragma unroll
                    for (int i = 0; i < 16; ++i) o[db][i] *= corr;
            }
            bf16x8 pf0 = pack8(pv[0], pv[1], pv[2], pv[3], pv[4], pv[5], pv[6], pv[7]);
            bf16x8 pf1 = pack8(pv[8], pv[9], pv[10], pv[11], pv[12], pv[13], pv[14], pv[15]);
#pragma unroll
            for (int db = 0; db < 4; ++db) {
                const u16* vp = Vs + (db * 32 + r) * 72 + sub * 32 + 4 * h;
                o[db] = MFMA(ld2x8(vp, vp + 8), pf0, o[db]);
                o[db] = MFMA(ld2x8(vp + 16, vp + 24), pf1, o[db]);
            }
        }
        if (!more) break;
        __syncthreads();
        ASTORE();
        __syncthreads();
        tile = ntile;
    }
#undef ALOAD
#undef ASTORE
    l += __shfl_xor(l, 32);
    const float inv = 1.f / l;
    const float* gates = (const float*)(ws + WS_GATES);
    const float gt = gates[tq * 24 + hq * 3 + (MODE == 0 ? 2 : 1)] * inv;
    float* onsa = (float*)(ws + WS_ONSA);
    u16* mix = (u16*)(ws + WS_MIX);
#pragma unroll
    for (int db = 0; db < 4; ++db)
#pragma unroll
        for (int a = 0; a < 4; ++a) {
            const int d = db * 32 + 8 * a + 4 * h;
            float4* op = (float4*)&onsa[tq * 1024 + hq * 128 + d];
            float4 v = make_float4(o[db][4 * a] * gt, o[db][4 * a + 1] * gt, o[db][4 * a + 2] * gt, o[db][4 * a + 3] * gt);
            if (MODE == 0) *op = v;
            else {
                float4 pr = *op;
                float4 pc = *(const float4*)((const float*)(ws + WS_OC) + tq * 1024 + hq * 128 + d);
                u32x2 ov; ov[0] = pk2(pr.x + pc.x + v.x, pr.y + pc.y + v.y); ov[1] = pk2(pr.z + pc.z + v.z, pr.w + pc.w + v.w);
                *(u32x2*)&mix[tq * 2048 + hq * 128 + d] = ov;
            }
        }
}

DI void cmp_item(const P& p, int it, char* smem) {
    size_t wsoff_ = 0; asm volatile("" : "+s"(wsoff_)); char* ws = p.ws + wsoff_;
    const int tid = TID(), lane = tid & 63, w = tid >> 6, r = lane & 31, h = lane >> 5;
    const int b = it >> 7, g = (it >> 6) & 1, qb = it & 63, q0 = qb * 32;
    const int hq = g * 4 + w;
    const u16* Q = (const u16*)(ws + WS_QN);
    const u16* K = (const u16*)(ws + WS_KCMP) + (size_t)(b * 2 + g) * 128 * 128;
    const u16* VT = (const u16*)(ws + WS_VCMPT) + (size_t)(b * 2 + g) * 128 * 128;
    const int qpos = q0 + r;
    const size_t tq = (size_t)b * 2048 + qpos;
    float* impb = (float*)smem;
    float* scb = (float*)(smem + 16384);
    __syncthreads();
    bf16x8 qf[8];
#pragma unroll
    for (int ks = 0; ks < 8; ++ks) qf[ks] = ldfrag(Q + tq * 1024 + hq * 128 + ks * 16 + h * 8);
    f32x16 s[4];
    float mx = NEG;
#pragma unroll
    for (int kb = 0; kb < 4; ++kb) {
        s[kb] = zero16();
        const u16* kp = K + (size_t)(kb * 32 + r) * 128 + h * 8;
#pragma unroll
        for (int ks = 0; ks < 8; ++ks) s[kb] = MFMA(ldfrag(kp + ks * 16), qf[ks], s[kb]);
#pragma unroll
        for (int i = 0; i < 16; ++i) {
            const int n = kb * 32 + crow(i, h);
            const bool vis = (n < 127) && (16 * n + 31 <= qpos);
            float v = vis ? s[kb][i] * SC128 : NEG;
            s[kb][i] = v; mx = fmaxf(mx, v);
        }
    }
    mx = fmaxf(mx, __shfl_xor(mx, 32));
    float sum = 0.f;
#pragma unroll
    for (int kb = 0; kb < 4; ++kb)
#pragma unroll
        for (int i = 0; i < 16; ++i) {
            const int n = kb * 32 + crow(i, h);
            const bool vis = (n < 127) && (16 * n + 31 <= qpos);
            float e = vis ? __expf(s[kb][i] - mx) : 0.f;
            s[kb][i] = e; sum += e;
        }
    sum += __shfl_xor(sum, 32);
    const float inv = sum > 0.f ? 1.f / sum : 0.f;
#pragma unroll
    for (int kb = 0; kb < 4; ++kb)
#pragma unroll
        for (int i = 0; i < 16; ++i) s[kb][i] *= inv;
    {
        float G[4][4], lastp[4][4];
#pragma unroll
        for (int kb = 0; kb < 4; ++kb)
#pragma unroll
            for (int a = 0; a < 4; ++a) {
                G[kb][a] = s[kb][4 * a] + s[kb][4 * a + 1] + s[kb][4 * a + 2] + s[kb][4 * a + 3];
                lastp[kb][a] = __shfl_xor(s[kb][4 * a + 3], 32);
            }
#pragma unroll
        for (int kb = 0; kb < 4; ++kb)
#pragma unroll
            for (int a = 0; a < 4; ++a) {
                const int j = 8 * kb + 2 * a + h;
                float prevl;
                if (a > 0) prevl = lastp[kb][a - 1]; else if (kb > 0) prevl = lastp[kb - 1][3]; else prevl = 0.f;
                float add = h ? lastp[kb][a] : prevl;
                impb[(w * 32 + r) * 32 + j] = G[kb][a] + add;
            }
    }
    __builtin_amdgcn_sched_barrier(0);
    f32x16 o[4];
#pragma unroll
    for (int db = 0; db < 4; ++db) o[db] = zero16();
#pragma unroll
    for (int kb = 0; kb < 4; ++kb) {
        __builtin_amdgcn_sched_barrier(0);
        bf16x8 pf0 = pack8(s[kb][0], s[kb][1], s[kb][2], s[kb][3], s[kb][4], s[kb][5], s[kb][6], s[kb][7]);
        bf16x8 pf1 = pack8(s[kb][8], s[kb][9], s[kb][10], s[kb][11], s[kb][12], s[kb][13], s[kb][14], s[kb][15]);
#pragma unroll
        for (int db = 0; db < 4; ++db) {
            const u16* vp = VT + (size_t)(db * 32 + r) * 128 + kb * 32 + 4 * h;
            o[db] = MFMA(ld2x8(vp, vp + 8), pf0, o[db]);
            o[db] = MFMA(ld2x8(vp + 16, vp + 24), pf1, o[db]);
        }
    }
    {
        const float* gates = (const float*)(ws + WS_GATES);
        const float gt = gates[tq * 24 + hq * 3 + 0];
        float* onsa = (float*)(ws + WS_OC);
#pragma unroll
        for (int db = 0; db < 4; ++db)
#pragma unroll
            for (int a = 0; a < 4; ++a) {
                const int d = db * 32 + 8 * a + 4 * h;
                float4* op = (float4*)&onsa[tq * 1024 + hq * 128 + d];
                float4 pr;
                pr.x = o[db][4 * a] * gt; pr.y = o[db][4 * a + 1] * gt; pr.z = o[db][4 * a + 2] * gt; pr.w = o[db][4 * a + 3] * gt;
                *op = pr;
            }
    }
    __syncthreads();
    unsigned* selo = (unsigned*)(ws + WS_SEL) + (size_t)(b * 2 + g) * 2048;
#pragma unroll
    for (int itq = 0; itq < 4; ++itq) {
        const int q = w * 8 + itq * 2 + h;
        const int t = q0 + q, cur = t >> 6, j = r;
        float sc = impb[(0 * 32 + q) * 32 + j] + impb[(1 * 32 + q) * 32 + j] + impb[(2 * 32 + q) * 32 + j] + impb[(3 * 32 + q) * 32 + j];
        const bool forced = (j == 0) || (j == cur) || (j == cur - 1);
        if (forced) sc = 1e9f;
        if (!(j * 64 <= t)) sc = -1.f;
        scb[q * 32 + j] = sc;
        CBAR();
        int cnt = 0;
#pragma unroll
        for (int j2 = 0; j2 < 32; j2 += 4) {
            float4 x = *(const float4*)&scb[q * 32 + j2];
            cnt += (x.x > sc) || (x.x == sc && (j2 + 0) < j);
            cnt += (x.y > sc) || (x.y == sc && (j2 + 1) < j);
            cnt += (x.z > sc) || (x.z == sc && (j2 + 2) < j);
            cnt += (x.w > sc) || (x.w == sc && (j2 + 3) < j);
        }
        unsigned long long bal = __ballot(cnt < 16);
        unsigned mk = h ? (unsigned)(bal >> 32) : (unsigned)bal;
        if (r == 0) selo[t] = mk;
    }
}

DI void retstate_item(const P& p, int it) {
    size_t wsoff_ = 0; asm volatile("" : "+s"(wsoff_)); char* ws = p.ws + wsoff_;
    const int lane = TID() & 63, w = TID() >> 6, r = lane & 31, h = lane >> 5;
    const int c = it & 15, bh = it >> 4;
    const u16* VT = (const u16*)(ws + WS_RVT) + (size_t)bh * 128 * 2048 + c * 128;
    const u16* KT = (const u16*)(ws + WS_RKZT) + (size_t)bh * 128 * 2048 + c * 128;
    f32x16 acc[4];
#pragma unroll
    for (int db = 0; db < 4; ++db) acc[db] = zero16();
#pragma unroll
    for (int ks = 0; ks < 8; ++ks) {
        bf16x8 a = ldfrag(VT + (size_t)(w * 32 + r) * 2048 + ks * 16 + h * 8);
#pragma unroll
        for (int db = 0; db < 4; ++db) acc[db] = MFMA(a, ldfrag(KT + (size_t)(db * 32 + r) * 2048 + ks * 16 + h * 8), acc[db]);
    }
    float* dst = (float*)(ws + WS_SST) + (size_t)it * 128 * 128;
#pragma unroll
    for (int db = 0; db < 4; ++db)
#pragma unroll
        for (int i = 0; i < 16; ++i) dst[(w * 32 + crow(i, h)) * 128 + db * 32 + r] = acc[db][i];
}

DI void cmpfin_item(const P& p, int L, int it, char* smem) {
    size_t wsoff_ = 0; asm volatile("" : "+s"(wsoff_)); char* ws = p.ws + wsoff_;
    const int tid = TID();
    const int i = it >> 7, r0 = (it & 127) * 8;
    float* biasS = (float*)smem;
    float* hS = (float*)(smem + 512);
    __syncthreads();
    if (tid < 128) {
        const float* pb = (const float*)(ws + WS_POSB) + (size_t)(L * 2 + i) * 64 * 128;
        float sacc = 0.f;
#pragma unroll 8
        for (int q = 0; q < 64; ++q) sacc += pb[q * 128 + tid];
        biasS[tid] = sacc;
    }
    __syncthreads();
    {
        const int row = tid >> 5, k4 = (tid & 31) * 4;
        const float* part = (const float*)(ws + WS_CPART) + (size_t)(i * 8) * 1024 * 128 + (size_t)(r0 + row) * 128 + k4;
        float4 a = make_float4(0.f, 0.f, 0.f, 0.f);
#pragma unroll
        for (int ksp = 0; ksp < 8; ++ksp) { float4 x = *(const float4*)(part + (size_t)ksp * 1024 * 128); a.x += x.x; a.y += x.y; a.z += x.z; a.w += x.w; }
        hS[row * 128 + k4 + 0] = gelu_erf(a.x + biasS[k4 + 0]); hS[row * 128 + k4 + 1] = gelu_erf(a.y + biasS[k4 + 1]);
        hS[row * 128 + k4 + 2] = gelu_erf(a.z + biasS[k4 + 2]); hS[row * 128 + k4 + 3] = gelu_erf(a.w + biasS[k4 + 3]);
    }
    __syncthreads();
    {
        const int n = tid & 127, rh = tid >> 7;
        const float* w2 = lnd(p.in[I_CW2]) + (size_t)(L * 2 + i) * 128 * 128;
        float acc0 = 0.f, acc1 = 0.f, acc2 = 0.f, acc3 = 0.f;
#pragma unroll 8
        for (int k = 0; k < 128; ++k) {
            const float wv = w2[k * 128 + n];
            acc0 += hS[(rh * 4 + 0) * 128 + k] * wv; acc1 += hS[(rh * 4 + 1) * 128 + k] * wv;
            acc2 += hS[(rh * 4 + 2) * 128 + k] * wv; acc3 += hS[(rh * 4 + 3) * 128 + k] * wv;
        }
        u16* kc = (u16*)(ws + WS_KCMP); u16* vt = (u16*)(ws + WS_VCMPT);
        float accs[4] = {acc0, acc1, acc2, acc3};
#pragma unroll
        for (int j = 0; j < 4; ++j) {
            const int row = r0 + rh * 4 + j;
            const int b = row >> 8, nn = (row >> 1) & 127, gg = row & 1;
            const u16 v = (nn == 127) ? (u16)0 : f2bf(accs[j]);
            if (i == 0) kc[((size_t)(b * 2 + gg) * 128 + nn) * 128 + n] = v;
            else vt[((size_t)(b * 2 + gg) * 128 + n) * 128 + nn] = v;
        }
    }
}

DI void retscan_item(const P& p, int it) {
    size_t wsoff_ = 0; asm volatile("" : "+s"(wsoff_)); char* ws = p.ws + wsoff_;
    const int tid = TID();
    const int eb = it & 15, bh = it >> 4, hh = bh & 7;
    const float log2g = log2f(1.f - exp2f(-5.f - (float)hh));
    const float cdec = exp2f(128.f * log2g);
    const int e = eb * 1024 + tid * 4;
    const float* sb = (const float*)(ws + WS_SST) + (size_t)(bh * 16) * 16384 + e;
    u16* rb = (u16*)(ws + WS_RBUF) + (size_t)(bh * 16) * 16384 + e;
    float4 x[15];
#pragma unroll
    for (int c = 0; c < 15; ++c) x[c] = *(const float4*)(sb + (size_t)c * 16384);
    float4 R = make_float4(0.f, 0.f, 0.f, 0.f);
    u32x2 z; z[0] = 0u; z[1] = 0u;
    *(u32x2*)rb = z;
#pragma unroll
    for (int c = 0; c < 15; ++c) {
        R.x = R.x * cdec + x[c].x; R.y = R.y * cdec + x[c].y; R.z = R.z * cdec + x[c].z; R.w = R.w * cdec + x[c].w;
        u32x2 pk; pk[0] = pk2(R.x, R.y); pk[1] = pk2(R.z, R.w);
        *(u32x2*)(rb + (size_t)(c + 1) * 16384) = pk;
    }
}

DI void retout_item(const P& p, int L, int it, char* smem) {
    size_t wsoff_ = 0; asm volatile("" : "+s"(wsoff_)); char* ws = p.ws + wsoff_;
    const int tid = TID(), lane = tid & 63, w = tid >> 6, r = lane & 31, h = lane >> 5;
    const int c = it & 15, bh = it >> 4, hh = bh & 7, b = bh >> 3;
    const float log2g = log2f(1.f - exp2f(-5.f - (float)hh));
    const float cdec = exp2f(128.f * log2g);
    const u16* Rt = (const u16*)(ws + WS_RBUF) + (size_t)(bh * 16 + c) * 16384;
    const int i0 = w * 32, iq = i0 + r;
    const size_t tq = (size_t)b * 2048 + c * 128 + iq;
    const u16* Q = (const u16*)(ws + WS_RQ);
    const u16* K = (const u16*)(ws + WS_RK);
    const u16* VT = (const u16*)(ws + WS_RVT) + (size_t)bh * 128 * 2048 + c * 128;
    bf16x8 qf[8];
#pragma unroll
    for (int ks = 0; ks < 8; ++ks) qf[ks] = ldfrag(Q + tq * 1024 + hh * 128 + ks * 16 + h * 8);
    f32x16 o[4];
#pragma unroll
    for (int vb = 0; vb < 4; ++vb) {
        o[vb] = zero16();
#pragma unroll
        for (int ks = 0; ks < 8; ++ks) o[vb] = MFMA(ldfrag(Rt + (vb * 32 + r) * 128 + ks * 16 + h * 8), qf[ks], o[vb]);
    }
    const float xi = exp2f((float)(iq + 1) * log2g);
#pragma unroll
    for (int vb = 0; vb < 4; ++vb)
#pragma unroll
        for (int i = 0; i < 16; ++i) o[vb][i] *= xi;
    for (int jb = 0; jb <= w; ++jb) {
        f32x16 s = zero16();
        const u16* kp = K + ((size_t)b * 2048 + c * 128 + jb * 32 + r) * 1024 + hh * 128 + h * 8;
#pragma unroll
        for (int ks = 0; ks < 8; ++ks) s = MFMA(ldfrag(kp + ks * 16), qf[ks], s);
        float pv[16];
#pragma unroll
        for (int i = 0; i < 16; ++i) {
            const int j = jb * 32 + crow(i, h);
            const int df = iq - j;
            pv[i] = (df >= 0) ? s[i] * exp2f((float)df * log2g) : 0.f;
        }
        bf16x8 pf0 = pack8(pv[0], pv[1], pv[2], pv[3], pv[4], pv[5], pv[6], pv[7]);
        bf16x8 pf1 = pack8(pv[8], pv[9], pv[10], pv[11], pv[12], pv[13], pv[14], pv[15]);
#pragma unroll
        for (int vb = 0; vb < 4; ++vb) {
            const u16* vp = VT + (size_t)(vb * 32 + r) * 2048 + jb * 32 + 4 * h;
            o[vb] = MFMA(ld2x8(vp, vp + 8), pf0, o[vb]);
            o[vb] = MFMA(ld2x8(vp + 16, vp + 24), pf1, o[vb]);
        }
    }
    float sm = 0.f;
#pragma unroll
    for (int vb = 0; vb < 4; ++vb)
#pragma unroll
        for (int i = 0; i < 16; ++i) sm += o[vb][i];
    sm += __shfl_xor(sm, 32);
    const float mu = sm * (1.f / 128.f);
    float vs = 0.f;
#pragma unroll
    for (int vb = 0; vb < 4; ++vb)
#pragma unroll
        for (int i = 0; i < 16; ++i) { float dlt = o[vb][i] - mu; vs += dlt * dlt; }
    vs += __shfl_xor(vs, 32);
    const float rs = rsqrtf(vs * (1.f / 128.f) + 1e-5f);
    const float* gg = lnd(p.in[I_GNG]) + L * 1024 + hh * 128;
    const float* gb = lnd(p.in[I_GNB]) + L * 1024 + hh * 128;
    const u16* rgs = (const u16*)(ws + WS_RGS) + tq * 1024 + hh * 128;
    u16* mix = (u16*)(ws + WS_MIX) + tq * 2048 + 1024 + hh * 128;
#pragma unroll
    for (int vb = 0; vb < 4; ++vb)
#pragma unroll
        for (int a = 0; a < 4; ++a) {
            const int v0 = vb * 32 + 8 * a + 4 * h;
            float4 g4 = *(const float4*)&gg[v0], b4 = *(const float4*)&gb[v0];
            u32x2 gt = *(const u32x2*)&rgs[v0];
            float y0 = ((o[vb][4 * a] - mu) * rs * g4.x + b4.x) * bflo(gt[0]);
            float y1 = ((o[vb][4 * a + 1] - mu) * rs * g4.y + b4.y) * bfhi(gt[0]);
            float y2 = ((o[vb][4 * a + 2] - mu) * rs * g4.z + b4.z) * bflo(gt[1]);
            float y3 = ((o[vb][4 * a + 3] - mu) * rs * g4.w + b4.w) * bfhi(gt[1]);
            u32x2 ov; ov[0] = pk2(y0, y1); ov[1] = pk2(y2, y3);
            *(u32x2*)&mix[v0] = ov;
        }
}

DI void xattn_item(const P& p, int it, char* smem) {
    size_t wsoff_ = 0; asm volatile("" : "+s"(wsoff_)); char* ws = p.ws + wsoff_;
    const int tid = TID(), lane = tid & 63, w = tid >> 6, r = lane & 31, h = lane >> 5;
    const int qb = it & 31, head = (it >> 5) & 3, b = it >> 7;
    const size_t t0 = (size_t)b * 2048 + qb * 64;
    const u16* Qg = (const u16*)(ws + WS_XQ) + t0 * 2048 + head * 512;
    const u16* Kg = (const u16*)(ws + WS_XK) + (size_t)(b * 256) * 2048 + head * 512;
    u16* Kc = (u16*)smem;
    u16* Qc = (u16*)(smem + 36864);
    float* mxs = (float*)(smem + 46080);
    float* sms = mxs + 256;
    u16* Pq = (u16*)smem;
    const u16* kgp = Kg + (size_t)(tid >> 3) * 2048 + (tid & 7) * 8;
    const u16* qgp = Qg + (size_t)(tid >> 3) * 2048 + (tid & 7) * 8;
    u32x4 kr[8], qr[2];
    f32x16 s[2][2];
#pragma unroll
    for (int a = 0; a < 2; ++a)
#pragma unroll
        for (int c = 0; c < 2; ++c) s[a][c] = zero16();
#define XLOAD(dc_) do { _Pragma("unroll") for (int i = 0; i < 8; ++i) kr[i] = *(const u32x4*)(kgp + (size_t)(i * 32) * 2048 + (dc_) * 64); \
        qr[0] = *(const u32x4*)(qgp + (dc_) * 64); qr[1] = *(const u32x4*)(qgp + (size_t)32 * 2048 + (dc_) * 64); } while (0)
#define XSTORE() do { _Pragma("unroll") for (int i = 0; i < 8; ++i) *(u32x4*)&Kc[((tid >> 3) + i * 32) * 72 + (tid & 7) * 8] = kr[i]; \
        *(u32x4*)&Qc[(tid >> 3) * 72 + (tid & 7) * 8] = qr[0]; *(u32x4*)&Qc[((tid >> 3) + 32) * 72 + (tid & 7) * 8] = qr[1]; } while (0)
    XLOAD(0);
    __syncthreads();
    XSTORE();
    __syncthreads();
#pragma unroll 1
    for (int dc = 0; dc < 8; ++dc) {
        if (dc + 1 < 8) XLOAD(dc + 1);
#pragma unroll
        for (int ks = 0; ks < 4; ++ks) {
            bf16x8 kf0 = *(const bf16x8*)&Kc[(w * 64 + r) * 72 + ks * 16 + h * 8];
            bf16x8 kf1 = *(const bf16x8*)&Kc[(w * 64 + 32 + r) * 72 + ks * 16 + h * 8];
            bf16x8 qf0 = *(const bf16x8*)&Qc[r * 72 + ks * 16 + h * 8];
            bf16x8 qf1 = *(const bf16x8*)&Qc[(32 + r) * 72 + ks * 16 + h * 8];
            s[0][0] = MFMA(kf0, qf0, s[0][0]); s[0][1] = MFMA(kf0, qf1, s[0][1]);
            s[1][0] = MFMA(kf1, qf0, s[1][0]); s[1][1] = MFMA(kf1, qf1, s[1][1]);
        }
        __syncthreads();
        if (dc + 1 < 8) { XSTORE(); __syncthreads(); }
    }
#undef XLOAD
#undef XSTORE
#pragma unroll
    for (int qg = 0; qg < 2; ++qg) {
        float mx = NEG;
#pragma unroll
        for (int kb = 0; kb < 2; ++kb)
#pragma unroll
            for (int i = 0; i < 16; ++i) { s[kb][qg][i] *= SC512; mx = fmaxf(mx, s[kb][qg][i]); }
        mx = fmaxf(mx, __shfl_xor(mx, 32));
        if (h == 0) mxs[w * 64 + qg * 32 + r] = mx;
    }
    __syncthreads();
    float linv[2];
#pragma unroll
    for (int qg = 0; qg < 2; ++qg) {
        const int q = qg * 32 + r;
        const float gm = fmaxf(fmaxf(mxs[q], mxs[64 + q]), fmaxf(mxs[128 + q], mxs[192 + q]));
        float sum = 0.f;
#pragma unroll
        for (int kb = 0; kb < 2; ++kb) {
#pragma unroll
            for (int i = 0; i < 16; ++i) { float e = __expf(s[kb][qg][i] - gm); s[kb][qg][i] = e; sum += e; }
#pragma unroll
            for (int a = 0; a < 4; ++a) {
                u32x2 v; v[0] = pk2(s[kb][qg][4 * a], s[kb][qg][4 * a + 1]); v[1] = pk2(s[kb][qg][4 * a + 2], s[kb][qg][4 * a + 3]);
                *(u32x2*)&Pq[q * 264 + w * 64 + kb * 32 + 8 * a + 4 * h] = v;
            }
        }
        sum += __shfl_xor(sum, 32);
        if (h == 0) sms[w * 64 + q] = sum;
    }
    __syncthreads();
#pragma unroll
    for (int qg = 0; qg < 2; ++qg) { const int q = qg * 32 + r; linv[qg] = 1.f / (sms[q] + sms[64 + q] + sms[128 + q] + sms[192 + q]); }
    const u16* VT = (const u16*)(ws + WS_XVT) + (size_t)((b * 4 + head) * 512 + w * 128) * 256;
    f32x16 o[4][2];
#pragma unroll
    for (int db = 0; db < 4; ++db) { o[db][0] = zero16(); o[db][1] = zero16(); }
#pragma unroll 4
    for (int kk = 0; kk < 16; ++kk) {
        bf16x8 pf0 = *(const bf16x8*)&Pq[r * 264 + kk * 16 + h * 8];
        bf16x8 pf1 = *(const bf16x8*)&Pq[(32 + r) * 264 + kk * 16 + h * 8];
#pragma unroll
        for (int db = 0; db < 4; ++db) {
            bf16x8 vf = ldfrag(VT + (size_t)(db * 32 + r) * 256 + kk * 16 + h * 8);
            o[db][0] = MFMA(vf, pf0, o[db][0]);
            o[db][1] = MFMA(vf, pf1, o[db][1]);
        }
    }
#pragma unroll
    for (int qg = 0; qg < 2; ++qg) {
        u16* xo = (u16*)(ws + WS_XO) + (t0 + qg * 32 + r) * 2048 + head * 512 + w * 128;
#pragma unroll
        for (int db = 0; db < 4; ++db)
#pragma unroll
            for (int a = 0; a < 4; ++a) {
                const int d = db * 32 + 8 * a + 4 * h;
                u32x2 ov; ov[0] = pk2(o[db][qg][4 * a] * linv[qg], o[db][qg][4 * a + 1] * linv[qg]); ov[1] = pk2(o[db][qg][4 * a + 2] * linv[qg], o[db][qg][4 * a + 3] * linv[qg]);
                *(u32x2*)&xo[d] = ov;
            }
    }
}

template <int NC, int NJ>
DI void ln_row_store(float (&y)[NC][NJ], const float* gam, const float* bet, float* dstf, u16* dstb, int lane) {
    float sm = 0.f;
#pragma unroll
    for (int c = 0; c < NC; ++c)
#pragma unroll
        for (int j = 0; j < NJ; ++j) sm += y[c][j];
    const float mu = wave_sum(sm) * (1.f / 2048.f);
    float vs = 0.f;
#pragma unroll
    for (int c = 0; c < NC; ++c)
#pragma unroll
        for (int j = 0; j < NJ; ++j) { float d = y[c][j] - mu; vs += d * d; }
    const float rs = rsqrtf(wave_sum(vs) * (1.f / 2048.f) + 1e-5f);
#pragma unroll
    for (int c = 0; c < NC; ++c)
#pragma unroll
        for (int j8 = 0; j8 < NJ; j8 += 8) {
            const int col = (c * 64 + lane) * NJ + j8;
            float4 g0 = *(const float4*)&gam[col], g1 = *(const float4*)&gam[col + 4];
            float4 b0 = *(const float4*)&bet[col], b1 = *(const float4*)&bet[col + 4];
            float4 o0, o1;
            o0.x = (y[c][j8 + 0] - mu) * rs * g0.x + b0.x; o0.y = (y[c][j8 + 1] - mu) * rs * g0.y + b0.y;
            o0.z = (y[c][j8 + 2] - mu) * rs * g0.z + b0.z; o0.w = (y[c][j8 + 3] - mu) * rs * g0.w + b0.w;
            o1.x = (y[c][j8 + 4] - mu) * rs * g1.x + b1.x; o1.y = (y[c][j8 + 5] - mu) * rs * g1.y + b1.y;
            o1.z = (y[c][j8 + 6] - mu) * rs * g1.z + b1.z; o1.w = (y[c][j8 + 7] - mu) * rs * g1.w + b1.w;
            *(float4*)&dstf[col] = o0; *(float4*)&dstf[col + 4] = o1;
            u32x4 pb = {pk2(o0.x, o0.y), pk2(o0.z, o0.w), pk2(o1.x, o1.y), pk2(o1.z, o1.w)};
            *(u32x4*)&dstb[col] = pb;
        }
}

DI void ln_phase(const P& p, const float* gam, const float* bet) {
    size_t wsoff_ = 0; asm volatile("" : "+s"(wsoff_)); char* ws = p.ws + wsoff_;
    const int lane = TID() & 63, w = TID() >> 6;
    const float* y = (const float*)(ws + WS_Y);
    float* xf = (float*)(ws + WS_XF); u16* xb = (u16*)(ws + WS_XB);
    for (int t = BID() * 4 + w; t < T; t += GDIM() * 4) {
        float v[4][8];
#pragma unroll
        for (int c = 0; c < 4; ++c) {
            const int col = (c * 64 + lane) * 8;
            float4 a = *(const float4*)&y[(size_t)t * 2048 + col], bq = *(const float4*)&y[(size_t)t * 2048 + col + 4];
            v[c][0] = a.x; v[c][1] = a.y; v[c][2] = a.z; v[c][3] = a.w; v[c][4] = bq.x; v[c][5] = bq.y; v[c][6] = bq.z; v[c][7] = bq.w;
        }
        ln_row_store(v, gam, bet, xf + (size_t)t * 2048, xb + (size_t)t * 2048, lane);
    }
}

DI unsigned fkey(float x) { unsigned u = __float_as_uint(x); return u ^ ((unsigned)((int)u >> 31) | 0x80000000u); }
DI int mbcnt64(unsigned long long m) { return __builtin_amdgcn_mbcnt_hi((unsigned)(m >> 32), __builtin_amdgcn_mbcnt_lo((unsigned)m, 0u)); }
DI float fkeyinv(unsigned k) { return __uint_as_float((k & 0x80000000u) ? (k ^ 0x80000000u) : ~k); }
template <bool TWO>
DI void wave_top16(unsigned k0, unsigned k1, unsigned pay0, unsigned pay1, int lane, unsigned* kk, unsigned* ki, unsigned* kp, int& rank, unsigned& okey, unsigned& opay) {
    unsigned T = 0u; int cntT = 1000;
#pragma unroll 1
    for (int bit = 31; bit >= 0; --bit) {
        const unsigned c = T | (1u << bit);
        int cnt = __builtin_popcountll(__builtin_amdgcn_ballot_w64(k0 >= c));
        if (TWO) cnt += __builtin_popcountll(__builtin_amdgcn_ballot_w64(k1 >= c));
        if (cnt >= 16) { T = c; cntT = cnt; if (cnt == 16) break; }
    }
    bool sel0, sel1;
    if (cntT == 16) { sel0 = k0 >= T; sel1 = TWO && (k1 >= T); }
    else {
        const bool gt0 = k0 > T, eq0 = k0 == T, gt1 = TWO && (k1 > T), eq1 = TWO && (k1 == T);
        const unsigned long long bg0 = __builtin_amdgcn_ballot_w64(gt0), bg1 = __builtin_amdgcn_ballot_w64(gt1);
        const unsigned long long be0 = __builtin_amdgcn_ballot_w64(eq0), be1 = __builtin_amdgcn_ballot_w64(eq1);
        const int need = 16 - (__builtin_popcountll(bg0) + __builtin_popcountll(bg1));
        sel0 = gt0 || (eq0 && mbcnt64(be0) < need);
        sel1 = gt1 || (eq1 && (__builtin_popcountll(be0) + mbcnt64(be1)) < need);
    }
    const unsigned long long bs0 = __builtin_amdgcn_ballot_w64(sel0), bs1 = __builtin_amdgcn_ballot_w64(sel1);
    CBAR();
    if (sel0) { const int sl = mbcnt64(bs0); kk[sl] = k0; ki[sl] = (unsigned)lane; kp[sl] = pay0; }
    if (sel1) { const int sl = __builtin_popcountll(bs0) + mbcnt64(bs1); kk[sl] = k1; ki[sl] = (unsigned)(lane + 64); kp[sl] = pay1; }
    CBAR();
    const int me = lane & 15;
    const unsigned myk = kk[me], myi = ki[me];
    opay = kp[me]; okey = myk;
    int c = 0;
#pragma unroll
    for (int j = 0; j < 16; j += 4) {
        const u32x4 a = *(const u32x4*)&kk[j]; const u32x4 bq = *(const u32x4*)&ki[j];
#pragma unroll
        for (int q = 0; q < 4; ++q) c += (a[q] > myk) || (a[q] == myk && bq[q] < myi);
    }
    CBAR();
    rank = c;
}

DI void peer_phase(const P& p, int L, char* smem, float* outp) {
    size_t wsoff_ = 0; asm volatile("" : "+s"(wsoff_)); char* ws = p.ws + wsoff_;
    const int lane = TID() & 63, w = TID() >> 6;
    char* wl = smem + w * 4096;
    float* sc = (float*)wl;
    float* s1s = sc + 128; int* i1s = (int*)(s1s + 16); float* s2s = (float*)(i1s + 16); int* i2s = (int*)(s2s + 16);
    float* cv = (float*)(i2s + 16);
    int* cp = (int*)(cv + 64);
    float* tv = (float*)(cp + 64);
    int* te = (int*)(tv + 16);
    int* exl = te + 16;
    float* gx = (float*)(exl + 128);
    const float* scores = (const float*)(ws + WS_SCORES);
    float* xf = (float*)(ws + WS_XF); u16* xb = (u16*)(ws + WS_XB);
    const unsigned char* ub = (const unsigned char*)(ws + WS_UB) + (size_t)L * 16384 * 1536;
    const unsigned char* vb = (const unsigned char*)(ws + WS_VB) + (size_t)L * 16384 * 1536;
    const float* gam = lnd(p.in[I_LN3G]) + L * 2048; const float* bet = lnd(p.in[I_LN3B]) + L * 2048;
    const int lane0 = lane;
    for (int t = BID() * 4 + w; t < T; t += GDIM() * 4) {
        int lane = lane0; asm volatile("" : "+v"(lane));
        int ca = 0, cb = lane;
        { int a = 0, rem = lane; for (; a < 16; ++a) { int cnt = 16 / (a + 1); if (rem < cnt) break; rem -= cnt; } ca = a; cb = rem; }
        const bool cvalid = ca < 16;
        const float* srow = scores + (size_t)t * 2048 + lane;
        float n00 = srow[0], n01 = srow[64], n10 = srow[128], n11 = srow[192];
        for (int hd2 = 0; hd2 < 8 * TOPK_REP; ++hd2) { const int hd = hd2 & 7;
            const float c00 = n00, c01 = n01, c10 = n10, c11 = n11;
            { const int hn = ((hd2 + 1) & 7) * 256; n00 = srow[hn]; n01 = srow[hn + 64]; n10 = srow[hn + 128]; n11 = srow[hn + 192]; }
            for (int p2 = 0; p2 < 2; ++p2) {
                const float v0 = p2 ? c10 : c00, v1 = p2 ? c11 : c01;
                int rk; unsigned ok, op;
                wave_top16<true>(fkey(v0), fkey(v1), (unsigned)lane, (unsigned)(lane + 64), lane, (unsigned*)cv, (unsigned*)cp, (unsigned*)cv + 16, rk, ok, op);
                float* ss = p2 ? s2s : s1s; int* is = p2 ? i2s : i1s;
                if (lane < 16) { ss[rk] = fkeyinv(ok); is[rk] = (int)op; }
                CBAR();
            }
            float val = 0.f; int eid = 0; unsigned ckey = 0u;
            if (cvalid) { val = s1s[ca] + s2s[cb]; eid = i1s[ca] * 128 + i2s[cb]; ckey = fkey(val); }
            CBAR();
            {
                int rk; unsigned ok, op;
                wave_top16<false>(ckey, 0u, (unsigned)eid, 0u, lane, (unsigned*)cv, (unsigned*)cp, (unsigned*)cv + 16, rk, ok, op);
                if (lane < 16) { tv[rk] = fkeyinv(ok); te[rk] = (int)op; }
            }
            CBAR();
            {
                const int li = lane & 15;
                const float tmax = tv[0];
                float e = __expf(tv[li] - tmax);
                float sum = e;
                sum += __shfl_xor(sum, 1); sum += __shfl_xor(sum, 2); sum += __shfl_xor(sum, 4); sum += __shfl_xor(sum, 8);
                if (lane < 16) { gx[hd * 16 + lane] = e / sum; exl[hd * 16 + lane] = te[lane]; }
            }
            CBAR();
        }
        asm volatile("" : "+v"(lane));
        float x[1][32], acc[1][32];
        const float* xr = xf + (size_t)t * 2048 + lane * 32;
#pragma unroll
        for (int q = 0; q < 8; ++q) {
            float4 a = *(const float4*)&xr[4 * q];
            x[0][4 * q] = a.x; x[0][4 * q + 1] = a.y; x[0][4 * q + 2] = a.z; x[0][4 * q + 3] = a.w;
        }
#pragma unroll
        for (int j = 0; j < 32; ++j) acc[0][j] = 0.f;
        const unsigned voff24 = (unsigned)lane * 24u;
#pragma unroll 1
        for (int k = 0; k < 128; k += 4) {
            int e[4]; float gq[4];
#pragma unroll
            for (int q = 0; q < 4; ++q) { e[q] = __builtin_amdgcn_readfirstlane(exl[k + q]); gq[q] = gx[k + q]; }
            u32x6 ua[4], va[4];
#pragma unroll
            for (int q = 0; q < 4; ++q) {
                const u32x2* sp = (const u32x2*)((ub + (size_t)e[q] * 1536) + (size_t)voff24);
                const u32x2 a0 = sp[0], a1 = sp[1], a2 = sp[2];
                ua[q][0] = a0[0]; ua[q][1] = a0[1]; ua[q][2] = a1[0]; ua[q][3] = a1[1]; ua[q][4] = a2[0]; ua[q][5] = a2[1];
            }
#pragma unroll
            for (int q = 0; q < 4; ++q) {
                const u32x2* sp = (const u32x2*)((vb + (size_t)e[q] * 1536) + (size_t)voff24);
                const u32x2 a0 = sp[0], a1 = sp[1], a2 = sp[2];
                va[q][0] = a0[0]; va[q][1] = a0[1]; va[q][2] = a1[0]; va[q][3] = a1[1]; va[q][4] = a2[0]; va[q][5] = a2[1];
            }
            float d[4];
#pragma unroll
            for (int q = 0; q < 4; ++q) {
                const f32x32 uu = __builtin_amdgcn_cvt_scalef32_pk32_f32_fp6(ua[q], 1.0f);
                float dd = 0.f;
#pragma unroll
                for (int j = 0; j < 32; ++j) dd += x[0][j] * uu[j];
                d[q] = dd;
                if (q < 3) { unsigned t0 = ua[q + 1][0]; asm volatile("" : "+v"(t0) : "v"(dd)); ua[q + 1][0] = t0; }
            }
#pragma unroll
            for (int q = 0; q < 4; ++q) d[q] = wave_sum(d[q]);
            float f[4];
            {
                const float dsel = (lane & 32) ? ((lane & 16) ? d[3] : d[2]) : ((lane & 16) ? d[1] : d[0]);
                const float gsel = (lane & 32) ? ((lane & 16) ? gq[3] : gq[2]) : ((lane & 16) ? gq[1] : gq[0]);
                const float fsel = gsel * gelu_erf(dsel * (1.f / 64.f)) * (1.f / 8.f);
#pragma unroll
                for (int q = 0; q < 4; ++q) f[q] = __int_as_float(__builtin_amdgcn_readlane(__float_as_int(fsel), q * 16));
            }
#pragma unroll
            for (int q = 0; q < 4; ++q) {
                const f32x32 vv = __builtin_amdgcn_cvt_scalef32_pk32_f32_fp6(va[q], 1.0f);
#pragma unroll
                for (int j = 0; j < 32; ++j) acc[0][j] += f[q] * vv[j];
                if (q < 3) { unsigned t0 = va[q + 1][0]; asm volatile("" : "+v"(t0) : "v"(acc[0][0])); va[q + 1][0] = t0; }
            }
        }
#pragma unroll
        for (int j = 0; j < 32; ++j) acc[0][j] += ALPHA * x[0][j];
        ln_row_store<1, 32>(acc, gam, bet, outp + (size_t)t * 2048, xb + (size_t)t * 2048, lane);
    }
}

DI void prep_phase(const P& p, char* smem) {
    size_t wsoff_ = 0; asm volatile("" : "+s"(wsoff_)); char* ws = p.ws + wsoff_;
    const size_t gtid = (size_t)BID() * 256 + TID(), gsz = (size_t)GDIM() * 256;
    {
        const float* x = lnd(p.in[I_X]); u16* xb = (u16*)(ws + WS_XB);
        for (size_t i = gtid; i < (size_t)T * 2048 / 8; i += gsz) {
            float4 a = *(const float4*)&x[i * 8], b = *(const float4*)&x[i * 8 + 4];
            u32x4 o = {pk2(a.x, a.y), pk2(a.z, a.w), pk2(b.x, b.y), pk2(b.z, b.w)};
            *(u32x4*)&xb[i * 8] = o;
        }
        const float* mm = lnd(p.in[I_MEM]); u16* mb = (u16*)(ws + WS_MEMB);
        for (size_t i = gtid; i < (size_t)1024 * 2048 / 8; i += gsz) {
            float4 a = *(const float4*)&mm[i * 8], b = *(const float4*)&mm[i * 8 + 4];
            u32x4 o = {pk2(a.x, a.y), pk2(a.z, a.w), pk2(b.x, b.y), pk2(b.z, b.w)};
            *(u32x4*)&mb[i * 8] = o;
        }
    }
    {
        int* sigs = (int*)(smem + 36864);
        __syncthreads();
        {
            f32x16v pa, pbv, qa, qb;
#pragma unroll
            for (int i = 0; i < 16; ++i) { pa[i] = (float)(i & 7); pbv[i] = (float)((16 + i) & 7); qa[i] = (float)(i >> 3); qb[i] = (float)((16 + i) >> 3); }
            const u32x6 e1 = __builtin_amdgcn_cvt_scalef32_2xpk16_fp6_f32(pa, pbv, 1.0f);
            const u32x6 e2 = __builtin_amdgcn_cvt_scalef32_2xpk16_fp6_f32(qa, qb, 1.0f);
            const f32x32 d1 = __builtin_amdgcn_cvt_scalef32_pk32_f32_fp6(e1, 1.0f);
            const f32x32 d2 = __builtin_amdgcn_cvt_scalef32_pk32_f32_fp6(e2, 1.0f);
            if (TID() == 0) {
#pragma unroll
                for (int j = 0; j < 32; ++j) { const int slot = ((int)(d1[j] + 0.5f) + 8 * (int)(d2[j] + 0.5f)) & 31; sigs[slot] = j; }
            }
        }
        __syncthreads();
        __builtin_amdgcn_sched_barrier(0);
        { int lz = 0; asm volatile("" : "+v"(lz)); sigs += lz; }
        const float* u = lnd(p.in[I_PU]); const float* v = lnd(p.in[I_PV]);
        unsigned char* ub = (unsigned char*)(ws + WS_UB); unsigned char* vb = (unsigned char*)(ws + WS_VB);
        const size_t n32 = (size_t)2 * 16384 * 2048 / 32;
        const int lane_ = TID() & 63, w_ = TID() >> 6;
        float* wreg = (float*)(smem + w_ * 8448);
        for (size_t i = gtid; i < n32; i += gsz) {
            const size_t wbase = (i - (size_t)lane_) * 32;
#pragma unroll 1
            for (int tb = 0; tb < 2; ++tb) {
                const float* src = (tb ? v : u) + wbase;
                const float scl = tb ? 8.f : 64.f;
                CBAR();
#pragma unroll
                for (int k = 0; k < 8; ++k) {
                    const float4 v4 = *(const float4*)(src + (size_t)(k * 64 + lane_) * 4);
                    float* d = wreg + (k * 8 + (lane_ >> 3)) * 33 + (lane_ & 7) * 4;
                    d[0] = v4.x; d[1] = v4.y; d[2] = v4.z; d[3] = v4.w;
                }
                CBAR();
                const float* mine = wreg + lane_ * 33;
                f32x16v xa, xb2;
#pragma unroll
                for (int q = 0; q < 16; q += 4) {
                    const int4 s0 = *(const int4*)&sigs[q], s1 = *(const int4*)&sigs[16 + q];
                    xa[q] = mine[s0.x] * scl; xa[q + 1] = mine[s0.y] * scl; xa[q + 2] = mine[s0.z] * scl; xa[q + 3] = mine[s0.w] * scl;
                    xb2[q] = mine[s1.x] * scl; xb2[q + 1] = mine[s1.y] * scl; xb2[q + 2] = mine[s1.z] * scl; xb2[q + 3] = mine[s1.w] * scl;
                }
                CBAR();
                const u32x6 o = __builtin_amdgcn_cvt_scalef32_2xpk16_fp6_f32(xa, xb2, 1.0f);
                u32x2 o0 = {o[0], o[1]}, o1 = {o[2], o[3]}, o2 = {o[4], o[5]};
                u32x2* dst = (u32x2*)((tb ? vb : ub) + i * 24); dst[0] = o0; dst[1] = o1; dst[2] = o2;
            }
        }
    }
    {
        float2* tab = (float2*)(ws + WS_ROPE);
        for (size_t i = gtid; i < (size_t)2048 * 64; i += gsz) {
            const int s = (int)(i >> 6), j = (int)(i & 63);
            const float inv = 1.0f / powf(10000.f, (float)(2 * j) / 128.f);
            const float ang = (float)s * inv;
            tab[i] = make_float2(cosf(ang), sinf(ang));
        }
    }
    {
        float* tl = (float*)smem;
        const int tid = TID();
        const int per_layer = 32 * 105 + 5 * 1024 + 256;
        const int n4 = (tid & 15) * 4, kr = tid >> 4;
        const float* src = nullptr; u16* dst = nullptr; int N = 0, Kd = 0, kt = 0, nt = 0;
        const float* nsrc = nullptr; u16* ndst = nullptr; int nN = 0, nKd = 0, nkt = 0, nnt = 0;
        float4 v0, v1, v2, v3;
#define TRDESC(it_, SRC, DST, NN, KD, KT, NT) do { const int L_ = (it_) / per_layer; int q_ = (it_) - L_ * per_layer; \
            u16* wl_ = (u16*)(ws + WS_WT) + (size_t)L_ * WT_LAYER; \
            if (q_ < 32 * 105) { SRC = lnd(p.in[I_WIN]) + (size_t)L_ * 2048 * PIN; DST = wl_ + WT_IN; NN = PIN; KD = 2048; KT = q_ / 105; NT = q_ - KT * 105; } \
            else if (q_ < 32 * 105 + 5 * 1024) { \
                q_ -= 32 * 105; const int m_ = q_ >> 10; q_ &= 1023; KT = q_ >> 5; NT = q_ & 31; NN = 2048; KD = 2048; \
                const int idx_ = (m_ == 0) ? I_WOUT : (m_ == 1) ? I_XWQ : (m_ == 2) ? I_XWK : (m_ == 3) ? I_XWV : I_XWO; \
                SRC = lnd(p.in[idx_]) + (size_t)L_ * 2048 * 2048; DST = wl_ + WT_OUT + (size_t)m_ * 2048 * 2048; \
            } else { \
                q_ -= 32 * 105 + 5 * 1024; const int i_ = q_ >> 7; q_ &= 127; KT = q_ >> 1; NT = q_ & 1; NN = 128; KD = 4096; \
                SRC = lnd(p.in[I_CW1]) + (size_t)(L_ * 2 + i_) * 4096 * 128; DST = wl_ + WT_CW1 + (size_t)i_ * 128 * 4096; \
            } } while (0)
#define TRLOAD(SRC, NN, KT, NT) do { const int n_ = (NT) * 64 + n4; const float4 z_ = make_float4(0.f, 0.f, 0.f, 0.f); v0 = z_; v1 = z_; v2 = z_; v3 = z_; \
            if (n_ < (NN)) { const float* b_ = (SRC) + (size_t)((KT) * 64 + kr) * (NN) + n_; \
                v0 = *(const float4*)(b_); v1 = *(const float4*)(b_ + (size_t)16 * (NN)); v2 = *(const float4*)(b_ + (size_t)32 * (NN)); v3 = *(const float4*)(b_ + (size_t)48 * (NN)); } } while (0)
        const int total = 2 * per_layer;
        int it = BID();
        if (it < total) { TRDESC(it, src, dst, N, Kd, kt, nt); TRLOAD(src, N, kt, nt); }
        for (; it < total; it += GDIM()) {
            const bool hn = it + GDIM() < total;
            __syncthreads();
            {
                float* t0 = tl + kr * 65 + n4;
                t0[0] = v0.x; t0[1] = v0.y; t0[2] = v0.z; t0[3] = v0.w;
                t0[16 * 65 + 0] = v1.x; t0[16 * 65 + 1] = v1.y; t0[16 * 65 + 2] = v1.z; t0[16 * 65 + 3] = v1.w;
                t0[32 * 65 + 0] = v2.x; t0[32 * 65 + 1] = v2.y; t0[32 * 65 + 2] = v2.z; t0[32 * 65 + 3] = v2.w;
                t0[48 * 65 + 0] = v3.x; t0[48 * 65 + 1] = v3.y; t0[48 * 65 + 2] = v3.z; t0[48 * 65 + 3] = v3.w;
            }
            if (hn) { TRDESC(it + GDIM(), nsrc, ndst, nN, nKd, nkt, nnt); TRLOAD(nsrc, nN, nkt, nnt); }
            __syncthreads();
#pragma unroll
            for (int i2 = 0; i2 < 2; ++i2) {
                const int c = tid + 256 * i2, n = c >> 3, kc = c & 7;
                if (nt * 64 + n < N) {
                    const float* tp = tl + (kc * 8) * 65 + n;
                    u32x4 o = {pk2(tp[0], tp[65]), pk2(tp[130], tp[195]), pk2(tp[260], tp[325]), pk2(tp[390], tp[455])};
                    *(u32x4*)&dst[(size_t)(nt * 64 + n) * Kd + kt * 64 + kc * 8] = o;
                }
            }
            src = nsrc; dst = ndst; N = nN; Kd = nKd; kt = nkt; nt = nnt;
        }
#undef TRDESC
#undef TRLOAD
    }
    {
        float* pb = (float*)(ws + WS_POSB);
        for (int it = BID(); it < 2 * 2 * 32; it += GDIM()) {
            const int part = it & 31, li = it >> 5;
            const int col = TID() & 127, half = TID() >> 7;
            const float* pos = lnd(p.in[I_CPOS]) + (size_t)li * 4096;
            const float* w1 = lnd(p.in[I_CW1]) + (size_t)li * 4096 * 128;
            const int r0 = part * 128 + half * 64;
            float s = 0.f;
            for (int q = 0; q < 64; ++q) s += pos[r0 + q] * w1[(size_t)(r0 + q) * 128 + col];
            pb[((size_t)li * 64 + part * 2 + half) * 128 + col] = s;
        }
    }
    {
        const int lane = TID() & 63, w = TID() >> 6, r = lane & 31, h = lane >> 5;
        for (int it = BID(); it < 2 * 16 * 16; it += GDIM()) {
            const int dblk = it & 15, hp = (it >> 4) & 15, L = it >> 8;
            const float* wq = lnd(p.in[I_PWQ]) + (size_t)L * 2048 * 2048;
            const float* sk = lnd(p.in[I_PSK]) + ((size_t)L * 16 + hp) * 128 * 128;
            u16* wpt = (u16*)(ws + WS_WT) + (size_t)L * WT_LAYER + WT_WP;
            const int d = dblk * 128 + w * 32 + r;
            f32x16 acc[4];
#pragma unroll
            for (int nb = 0; nb < 4; ++nb) acc[nb] = zero16();
#pragma unroll 1
            for (int ks = 0; ks < 8; ++ks) {
                const float* apx = wq + (size_t)d * 2048 + hp * 128 + ks * 16 + h * 8;
                float4 a0 = *(const float4*)apx, a1 = *(const float4*)(apx + 4);
                float av[8] = {a0.x, a0.y, a0.z, a0.w, a1.x, a1.y, a1.z, a1.w};
                float ahf[8], alf[8];
#pragma unroll
                for (int q = 0; q < 8; ++q) { ahf[q] = __uint_as_float((unsigned)f2bf(av[q]) << 16); alf[q] = av[q] - ahf[q]; }
                bf16x8 ah = pack8(ahf[0], ahf[1], ahf[2], ahf[3], ahf[4], ahf[5], ahf[6], ahf[7]);
                bf16x8 al = pack8(alf[0], alf[1], alf[2], alf[3], alf[4], alf[5], alf[6], alf[7]);
#pragma unroll
                for (int nb = 0; nb < 4; ++nb) {
                    const float* bpx = sk + (size_t)(nb * 32 + r) * 128 + ks * 16 + h * 8;
                    float4 b0 = *(const float4*)bpx, b1 = *(const float4*)(bpx + 4);
                    float bv[8] = {b0.x, b0.y, b0.z, b0.w, b1.x, b1.y, b1.z, b1.w};
                    float bhf[8], blf[8];
#pragma unroll
                    for (int q = 0; q < 8; ++q) { bhf[q] = __uint_as_float((unsigned)f2bf(bv[q]) << 16); blf[q] = bv[q] - bhf[q]; }
                    bf16x8 bh = pack8(bhf[0], bhf[1], bhf[2], bhf[3], bhf[4], bhf[5], bhf[6], bhf[7]);
                    bf16x8 bl = pack8(blf[0], blf[1], blf[2], blf[3], blf[4], blf[5], blf[6], blf[7]);
                    acc[nb] = MFMA(ah, bh, acc[nb]);
                    acc[nb] = MFMA(ah, bl, acc[nb]);
                    acc[nb] = MFMA(al, bh, acc[nb]);
                }
            }
#pragma unroll
            for (int nb = 0; nb < 4; ++nb)
#pragma unroll
                for (int a = 0; a < 4; ++a) {
                    u32x2 v; v[0] = pk2(acc[nb][4 * a], acc[nb][4 * a + 1]); v[1] = pk2(acc[nb][4 * a + 2], acc[nb][4 * a + 3]);
                    *(u32x2*)&wpt[(size_t)(hp * 128 + nb * 32 + r) * 2048 + dblk * 128 + w * 32 + 8 * a + 4 * h] = v;
                }
        }
    }
}

#define XB_TMO      128
#define XB_XCNT(j)  (256  + 64 * (j))
#define XB_XSUB(j)  (1280 + 64 * (j))
#define XB_XGEN(j)  (2304 + 64 * (j))
#define XB_TOP      3328
#define XB_TOPGEN   3392
#define XCD_BAR_WORDS 3456
#define XB_SPIN_CAP (1u << 18)
#define LAS __attribute__((address_space(3)))

__device__ __forceinline__ unsigned* xb_va(unsigned* p) { unsigned z = 0; asm volatile("" : "+v"(z)); return (unsigned*)((char*)p + (size_t)z); }
__device__ __forceinline__ unsigned xb_ld(unsigned* p)              { return __hip_atomic_load(xb_va(p), __ATOMIC_RELAXED, __HIP_MEMORY_SCOPE_AGENT); }
__device__ __forceinline__ unsigned xb_add(unsigned* p, unsigned v) { return __hip_atomic_fetch_add(xb_va(p), v, __ATOMIC_RELAXED, __HIP_MEMORY_SCOPE_AGENT); }
__device__ __forceinline__ unsigned xb_xcc_id() { return (unsigned)__builtin_amdgcn_s_getreg((3 << 11) | 20) & 0xFu; }
#define XB_SPIN(cond, bar) do { unsigned _sp = 0; while (cond) { __builtin_amdgcn_s_sleep(1); \
    if ((++_sp & 255u) == 0u) { if (xb_ld(&(bar)[XB_TMO])) break; if (_sp > XB_SPIN_CAP) { atomicAdd(&(bar)[XB_TMO], 1u); break; } } } } while (0)

struct XcdBarrier {
    unsigned* bar; unsigned x;
    volatile LAS unsigned* st;
};

__device__ __forceinline__ XcdBarrier xcd_barrier_post(unsigned* bar, volatile LAS unsigned* st) {
    XcdBarrier b; b.bar = bar; b.x = xb_xcc_id(); b.st = st;
    if (threadIdx.x == 0) (void)xb_add(&bar[XB_XCNT(b.x)], 1u);
    return b;
}
__device__ __forceinline__ void xcd_barrier_complete(unsigned* bar, unsigned x, unsigned& nloc, unsigned& nx) {
    const unsigned G = gridDim.x * gridDim.y * gridDim.z;
    unsigned sum, cnt, mine, sp = 0u;
    for (;;) {
        sum = 0u; cnt = 0u; mine = 0u;
#pragma unroll
        for (unsigned j = 0; j < 16; ++j) { const unsigned c = xb_ld(&bar[XB_XCNT(j)]); sum += c; cnt += (c > 0u) ? 1u : 0u; mine = (j == x) ? c : mine; }
        if (sum == G) break;
        __builtin_amdgcn_s_sleep(1);
        if ((++sp & 255u) == 0u) { if (xb_ld(&bar[XB_TMO])) break; if (sp > XB_SPIN_CAP) { atomicAdd(&bar[XB_TMO], 1u); break; } }
    }
    nloc = mine > 0u ? mine : 1u; nx = cnt > 0u ? cnt : 1u;
}

__device__ __forceinline__ void xcd_barrier(const XcdBarrier& b) {
    asm volatile("s_waitcnt vmcnt(0)" ::: "memory");
    __syncthreads();
    if (threadIdx.x == 0) {
        unsigned* bar = b.bar;
        const unsigned bx = xb_xcc_id();
        __builtin_amdgcn_s_waitcnt(0);
        unsigned nloc = b.st[0], nx = b.st[1];
        if (nloc == 0u) { xcd_barrier_complete(bar, bx, nloc, nx); b.st[0] = nloc; b.st[1] = nx; }
        const unsigned old = xb_add(&bar[XB_XSUB(bx)], 1u);
        const unsigned gen = old / nloc;
        if (old + 1u == (gen + 1u) * nloc) {
            __builtin_amdgcn_fence(__ATOMIC_RELEASE, "agent");
            asm volatile("s_waitcnt vmcnt(0)" ::: "memory");
            const unsigned og = xb_add(&bar[XB_TOP], 1u);
            const unsigned tg = og / nx;
            if (og + 1u == (tg + 1u) * nx) xb_add(&bar[XB_TOPGEN], 1u);
            else XB_SPIN(xb_ld(&bar[XB_TOPGEN]) == tg, bar);
            __builtin_amdgcn_fence(__ATOMIC_ACQUIRE, "agent");
            xb_add(&bar[XB_XGEN(bx)], 1u);
            asm volatile("s_waitcnt vmcnt(0)" ::: "memory");
        } else {
            XB_SPIN(xb_ld(&bar[XB_XGEN(bx)]) == gen, bar);
            __builtin_amdgcn_fence(__ATOMIC_ACQUIRE, "agent");
            asm volatile("s_waitcnt vmcnt(0)" ::: "memory");
        }
    }
    __syncthreads();
}


#ifndef REP_MASK
#define REP_MASK 0
#endif
#ifndef TOPK_REP
#define TOPK_REP 1
#endif
enum { K_GEMM = 0, K_ATTN0, K_ATTN1, K_RETSTATE, K_CMP, K_RETOUT, K_XATTN, K_CMPFIN, K_RETSCAN };

DI void make_desc(const P& p, int L, int ph, int it, const float* xres, GT& g) {
    size_t wsoff_ = 0; asm volatile("" : "+s"(wsoff_)); char* ws = p.ws + wsoff_;
    g.aux = nullptr; g.dst = nullptr; g.amode = 0; g.kbeg = 0; g.ncols = 128; g.e0 = 0; g.e1 = 0;
    if (ph == 0) {
        if (it < 53 * 32) { inproj_desc(p, L, it >> 5, it & 31, g); }
        else {
            int q = it - 53 * 32; int which = q >> 6; int nt = (q >> 2) & 15, mt = q & 3;
            g.A = (const u16*)(ws + WS_MEMB); g.lda = 2048; g.M = 1024; g.m0 = mt * 256; g.ldb = 2048; g.K = 2048;
            g.B = (const u16*)(ws + WS_WT) + (size_t)L * WT_LAYER + (which ? WT_XV : WT_XK) + (size_t)(nt * 128) * 2048;
            if (which == 0) { g.emode = E_PLAIN; g.dst = ws + WS_XK; g.e0 = 2048; g.e1 = nt * 128; }
            else { g.emode = E_XVT; g.dst = ws + WS_XVT; g.e0 = 0; g.e1 = nt * 128; }
        }
    } else if (ph == 1) {
        const int mt = it & 3, ksp = (it >> 2) & 7, i = it >> 5;
        g.A = (const u16*)(ws + (i ? WS_VC : WS_KC)); g.lda = 0; g.amode = 1; g.kbeg = ksp * 512; g.M = 1024; g.m0 = mt * 256;
        g.B = (const u16*)(ws + WS_WT) + (size_t)L * WT_LAYER + WT_CW1 + (size_t)i * 128 * 4096 + ksp * 512; g.ldb = 4096; g.K = 512;
        g.emode = E_F32; g.e0 = 128; g.e1 = 0; g.dst = ws + WS_CPART + (size_t)(i * 8 + ksp) * 1024 * 128 * 4;
    } else {
        const int nt = it >> 5, mt = it & 31;
        g.lda = 2048; g.M = T; g.m0 = mt * 256; g.ldb = 2048; g.K = 2048; g.e1 = nt * 128;
        const u16* wt = (const u16*)(ws + WS_WT) + (size_t)L * WT_LAYER;
        if (ph == 5) { g.A = (const u16*)(ws + WS_MIX); g.B = wt + WT_OUT + (size_t)(nt * 128) * 2048; g.emode = E_RESID; g.aux = xres; }
        else if (ph == 7) { g.A = (const u16*)(ws + WS_XB); g.B = wt + WT_XQ + (size_t)(nt * 128) * 2048; g.emode = E_PLAIN; g.e0 = 2048; g.dst = ws + WS_XQ; }
        else if (ph == 9) { g.A = (const u16*)(ws + WS_XO); g.B = wt + WT_XO + (size_t)(nt * 128) * 2048; g.emode = E_RESID; g.aux = (const float*)(ws + WS_XF); }
        else { g.A = (const u16*)(ws + WS_XB); g.B = wt + WT_WP + (size_t)(nt * 128) * 2048; g.emode = E_F32; g.e0 = 2048; g.dst = ws + WS_SCORES; }
    }
}

__global__ void __launch_bounds__(256, 2) mega(P p) {
    cg::grid_group grid = cg::this_grid();
    __shared__ __attribute__((aligned(16))) char smem[61440];
    size_t wsoff_ = 0; asm volatile("" : "+s"(wsoff_)); char* ws = p.ws + wsoff_;
    const int G = GDIM(), bid = BID();

    __shared__ uint4 xb_words;
    unsigned* barw = (unsigned*)(ws + WS_BAR);
    if (threadIdx.x == 0) xb_words = make_uint4(0u, 0u, 0u, 0u);
    __syncthreads();
    XcdBarrier xb = xcd_barrier_post(barw, (volatile LAS unsigned*)&xb_words);
    if (p.ws == nullptr) grid.sync();
    for (int rep = 0; rep < 1 + ((REP_MASK >> 13) & 1); ++rep) prep_phase(p, smem);
    xcd_barrier(xb);

#pragma unroll 1
    for (int L = 0; L < 2; ++L) {
        const float* xres = (L == 0) ? lnd(p.in[I_X]) : (const float*)(ws + WS_XF);
#pragma unroll 1
        for (int ph = 0; ph < 13; ++ph) {
#pragma unroll 1
            for (int rep = 0; rep < 1 + ((REP_MASK >> ph) & 1); ++rep)
            if (ph == 6 || ph == 10) {
                const int gi = (ph == 6) ? I_LN1G : I_LN2G;
                ln_phase(p, lnd(p.in[gi]) + L * 2048, lnd(p.in[gi + 1]) + L * 2048);
            } else if (ph == 12) {
                peer_phase(p, L, smem, (rep < ((REP_MASK >> 12) & 1)) ? (float*)(ws + WS_Y) : (L == 1) ? p.out : (float*)(ws + WS_XF));
            } else {
                int n = 512;
                if (ph == 0) n = 53 * 32 + 128; else if (ph == 1) n = 64 + 512 + 512; else if (ph == 2) n = 256 + 512; else if (ph == 3) n = 1024;
#pragma unroll 1
                for (int it = bid; it < n; it += G) {
                    int kind = K_GEMM, sub = it;
                    if (ph == 1) { if (it >= 576) { kind = K_RETSTATE; sub = it - 576; } else if (it >= 64) { kind = K_ATTN0; sub = it - 64; } }
                    else if (ph == 2) { if (it < 256) kind = K_CMPFIN; else { kind = K_RETSCAN; sub = it - 256; } }
                    else if (ph == 3) { if (it < 512) kind = K_CMP; else { kind = K_RETOUT; sub = it - 512; } }
                    else if (ph == 4) { kind = K_ATTN1; if (it >= 256) sub = it ^ 63; }
                    else if (ph == 8) kind = K_XATTN;
                    switch (kind) {
                    case K_GEMM: { GT g; make_desc(p, L, ph, sub, xres, g); gemm_tile(p, L, smem, g); } break;
                    case K_ATTN0: attn_item<0>(p, sub, smem); break;
                    case K_ATTN1: attn_item<1>(p, sub, smem); break;
                    case K_RETSTATE: retstate_item(p, sub); break;
                    case K_CMP: cmp_item(p, sub, smem); break;
                    case K_RETOUT: retout_item(p, L, sub, smem); break;
                    case K_XATTN: xattn_item(p, sub, smem); break;
                    case K_CMPFIN: cmpfin_item(p, L, sub, smem); break;
                    case K_RETSCAN: retscan_item(p, sub); break;
                    }
                }
            }
            { size_t bo = 0; asm volatile("" : "+s"(bo)); xb.bar = (unsigned*)(p.ws + bo + WS_BAR); }
            xcd_barrier(xb);
        }
    }
}

extern "C" void kernel_launch(void* const* d_in, const int* in_sizes, int n_in, void* d_out, int out_size, void* d_ws, size_t ws_size,
                              hipStream_t stream) {
    static int grid_blocks = 0;
    if (!grid_blocks) {
        int dev = 0, cus = 0, per_cu = 0;
        (void)hipGetDevice(&dev);
        (void)hipDeviceGetAttribute(&cus, hipDeviceAttributeMultiprocessorCount, dev);
        (void)hipOccupancyMaxActiveBlocksPerMultiprocessor(&per_cu, mega, 256, 0);
        if (per_cu > 2) per_cu = 2;
        if (per_cu < 1) per_cu = 1;
        grid_blocks = cus * per_cu;
        if (ws_size < WS_END) fprintf(stderr, "kernel_launch: workspace too small: %zu < %zu\n", ws_size, (size_t)WS_END);
    }
    P p{};
    for (int i = 0; i < 24; ++i) p.in[i] = (const float*)d_in[i];
    p.out = (float*)d_out;
    p.ws = (char*)d_ws;
    void* args[] = {&p};
    if (hipMemsetAsync((char*)d_ws + WS_BAR, 0, XCD_BAR_WORDS * sizeof(unsigned), stream) != hipSuccess) { fprintf(stderr, "kernel_launch: memset of the barrier words failed\n"); return; }
    hipError_t e = hipLaunchCooperativeKernel((void*)mega, dim3(grid_blocks), dim3(256), args, 0, stream);
    if (e != hipSuccess) fprintf(stderr, "cooperative launch failed: %s (grid %d)\n", hipGetErrorString(e), grid_blocks);
}
```

```cpp
#include <hip/hip_runtime.h>
#include <hip/hip_cooperative_groups.h>
#include <cstdio>
namespace cg = cooperative_groups;
#ifndef TOPK_REP
#define TOPK_REP 1
#endif

#define DI __device__ __forceinline__
typedef unsigned short u16;
using bf16x8 = __attribute__((ext_vector_type(8))) short;
using f32x16 = __attribute__((ext_vector_type(16))) float;
using u32x4 = __attribute__((ext_vector_type(4))) unsigned;
using u32x2 = __attribute__((ext_vector_type(2))) unsigned;
using u32x6 = __attribute__((ext_vector_type(6))) unsigned;
using f32x16v = __attribute__((ext_vector_type(16))) float;
using f32x32 = __attribute__((ext_vector_type(32))) float;
#define MFMA(a, b, c) __builtin_amdgcn_mfma_f32_32x32x16_bf16((a), (b), (c), 0, 0, 0)

static constexpr int T = 8192, D = 2048, S = 2048, NB = 4, PIN = 6680;
static constexpr float ALPHA = 1.4142135623730951f;
static constexpr float SC128 = 0.08838834764831845f;
static constexpr float SC512 = 0.04419417382415922f;
static constexpr float NEG = -1e30f;

enum { I_X = 0, I_MEM, I_WIN, I_BGATE, I_CPOS, I_CW1, I_CW2, I_GNG, I_GNB, I_WOUT, I_LN1G, I_LN1B, I_XWQ, I_XWK, I_XWV, I_XWO,
       I_LN2G, I_LN2B, I_PWQ, I_PSK, I_PU, I_PV, I_LN3G, I_LN3B };

static constexpr size_t MB = 1ull << 20;
static constexpr size_t WS_XB = 0;
static constexpr size_t WS_XF = WS_XB + 32 * MB;
static constexpr size_t WS_Y = WS_XF + 64 * MB;
static constexpr size_t WS_MEMB = WS_Y + 64 * MB;
static constexpr size_t WS_ROPE = WS_MEMB + 4 * MB;
static constexpr size_t WS_QN = WS_ROPE + 1 * MB;
static constexpr size_t WS_QR = WS_QN + 16 * MB;
static constexpr size_t WS_KC = WS_QR + 16 * MB;
static constexpr size_t WS_VC = WS_KC + 4 * MB;
static constexpr size_t WS_KS = WS_VC + 4 * MB;
static constexpr size_t WS_VST = WS_KS + 4 * MB;
static constexpr size_t WS_KW = WS_VST + 4 * MB;
static constexpr size_t WS_VWT = WS_KW + 4 * MB;
static constexpr size_t WS_GATES = WS_VWT + 4 * MB;
static constexpr size_t WS_RQ = WS_GATES + 1 * MB;
static constexpr size_t WS_RK = WS_RQ + 16 * MB;
static constexpr size_t WS_RKZT = WS_RK + 16 * MB;
static constexpr size_t WS_RVT = WS_RKZT + 16 * MB;
static constexpr size_t WS_RGS = WS_RVT + 16 * MB;
static constexpr size_t WS_XK = WS_RGS + 16 * MB;
static constexpr size_t WS_XVT = WS_XK + 4 * MB;
static constexpr size_t WS_CPART = WS_XVT + 4 * MB;
static constexpr size_t WS_KCMP = WS_CPART + 8 * MB;
static constexpr size_t WS_VCMPT = WS_KCMP + 1 * MB;
static constexpr size_t WS_POSB = WS_VCMPT + 1 * MB;
static constexpr size_t WS_WT = WS_POSB + 1 * MB;
static constexpr size_t WS_SST = WS_WT + 162 * MB;
static constexpr size_t WS_ONSA = WS_SST + 32 * MB;
static constexpr size_t WS_MIX = WS_ONSA + 32 * MB;
static constexpr size_t WS_SEL = WS_MIX + 32 * MB;
static constexpr size_t WS_XQ = WS_SEL + 1 * MB;
static constexpr size_t WS_XO = WS_XQ + 32 * MB;
static constexpr size_t WS_SCORES = WS_XO + 32 * MB;
static constexpr size_t WS_UB = WS_SCORES + 64 * MB;
static constexpr size_t WS_VB = WS_UB + 64 * MB;
static constexpr size_t WS_RBUF = WS_VB + 64 * MB;
static constexpr size_t WS_OC = WS_RBUF + 16 * MB;
static constexpr size_t WS_BAR = WS_OC + 32 * MB;
static constexpr size_t WS_END = WS_BAR + 1 * MB;

static constexpr size_t WT_IN = 0;
static constexpr size_t WT_OUT = (size_t)6784 * 2048;
static constexpr size_t WT_XQ = WT_OUT + (size_t)2048 * 2048;
static constexpr size_t WT_XK = WT_XQ + (size_t)2048 * 2048;
static constexpr size_t WT_XV = WT_XK + (size_t)2048 * 2048;
static constexpr size_t WT_XO = WT_XV + (size_t)2048 * 2048;
static constexpr size_t WT_WP = WT_XO + (size_t)2048 * 2048;
static constexpr size_t WT_CW1 = WT_WP + (size_t)2048 * 2048;
static constexpr size_t WT_LAYER = WT_CW1 + (size_t)2 * 128 * 4096;
static_assert(2 * WT_LAYER * 2 <= 162 * MB, "WT region");

struct P {
    const float* in[24];
    float* out;
    char* ws;
};

typedef float f32x2_t __attribute__((ext_vector_type(2)));
typedef __bf16 bf16x2_t __attribute__((ext_vector_type(2)));
DI unsigned pk2(float a, float b) { f32x2_t v = {a, b}; return __builtin_bit_cast(unsigned, __builtin_convertvector(v, bf16x2_t)); }
DI u16 f2bf(float x) { return (u16)(pk2(x, x) & 0xffffu); }
DI float bflo(unsigned v) { return __uint_as_float(v << 16); }
DI float bfhi(unsigned v) { return __uint_as_float(v & 0xffff0000u); }
DI const float* lnd(const float* q) { size_t o = 0; asm volatile("" : "+s"(o)); return q + o; }
DI int TID() { int t = threadIdx.x; asm volatile("" : "+v"(t)); return t; }
DI int BID() { int t = blockIdx.x; asm volatile("" : "+s"(t)); return t; }
DI int GDIM() { int t = gridDim.x; asm volatile("" : "+s"(t)); return t; }
DI int crow(int i, int h) { return (i & 3) + 8 * (i >> 2) + 4 * h; }
DI bf16x8 ldfrag(const u16* p) { return *(const bf16x8*)p; }
DI bf16x8 ld2x8(const u16* p0, const u16* p1) {
    u32x2 a = *(const u32x2*)p0; u32x2 b = *(const u32x2*)p1; u32x4 v = {a[0], a[1], b[0], b[1]};
    return __builtin_bit_cast(bf16x8, v);
}
DI bf16x8 pack8(float a0, float a1, float a2, float a3, float a4, float a5, float a6, float a7) {
    u32x4 v = {pk2(a0, a1), pk2(a2, a3), pk2(a4, a5), pk2(a6, a7)};
    return __builtin_bit_cast(bf16x8, v);
}
DI f32x16 zero16() { f32x16 z; for (int i = 0; i < 16; ++i) z[i] = 0.f; return z; }
DI float gelu_erf(float x) { return 0.5f * x * (1.f + erff(x * 0.7071067811865476f)); }
DI float wave_sum(float v) { for (int o = 32; o >= 1; o >>= 1) v += __shfl_xor(v, o); return v; }
#define CBAR() __asm__ volatile("" ::: "memory")

enum { E_QDUAL = 0, E_PLAIN, E_ROPE, E_VT, E_RK, E_GATE, E_SILU, E_XVT, E_RESID, E_F32 };
struct GT {
    const u16* A; int lda; int amode; int M; int m0; int kbeg;
    const u16* B; int ldb; int ncols; int K;
    int emode; int e0; int e1;
    void* dst; const float* aux;
};

DI void gemm_tile(const P& p, int L, char* smem, const GT& g) {
    u16* As = (u16*)smem;
    u16* Bs = (u16*)(smem + 36864);
    const int tid = TID(), lane = tid & 63, w = tid >> 6, r = lane & 31, h = lane >> 5;
    const int trow = tid >> 3, tkc = tid & 7;
    unsigned voffa, voffb;
    size_t astep;
    const u16* abase;
    if (g.amode == 0) { voffa = (unsigned)(trow * g.lda + tkc * 8) * 2u; astep = (size_t)32 * g.lda; abase = g.A + (size_t)g.m0 * g.lda; }
    else { voffa = (unsigned)((trow >> 1) * 4096 + (trow & 1) * 128 + tkc * 8) * 2u; astep = 65536; abase = g.A + (size_t)(g.m0 >> 8) * 2048 * 256; }
    voffb = (unsigned)(trow * g.ldb + tkc * 8) * 2u;
    const size_t bstep = (size_t)32 * g.ldb;
    const int brows = (g.ncols + 31) >> 5;
    f32x16 acc[2][4];
#pragma unroll
    for (int a = 0; a < 2; ++a)
#pragma unroll
        for (int b = 0; b < 4; ++b) acc[a][b] = zero16();
    u32x4 pa[8], pb[4];
#define GLOAD(k0_) do { const int k0 = (k0_); const int koff = g.amode ? (((k0 + g.kbeg) >> 7) * 256 + ((k0 + g.kbeg) & 127)) : k0; \
        _Pragma("unroll") for (int i = 0; i < 8; ++i) pa[i] = *(const u32x4*)((const char*)(abase + (size_t)i * astep + koff) + voffa); \
        _Pragma("unroll") for (int i = 0; i < 4; ++i) pb[i] = *(const u32x4*)((const char*)(g.B + (size_t)(i < brows ? i : 0) * bstep + k0) + voffb); } while (0)
#define SSTORE() do { \
        _Pragma("unroll") for (int i = 0; i < 8; ++i) *(u32x4*)&As[((tid >> 3) + 32 * i) * 72 + (tid & 7) * 8] = pa[i]; \
        _Pragma("unroll") for (int i = 0; i < 4; ++i) *(u32x4*)&Bs[((tid >> 3) + 32 * i) * 72 + (tid & 7) * 8] = pb[i]; } while (0)
#define RDA(ks_) do { fa[ks_][0] = *(const bf16x8*)(arp + (ks_) * 16); fa[ks_][1] = *(const bf16x8*)(arp + 32 * 72 + (ks_) * 16); } while (0)
#define RDB(ks_, nb_) fb[ks_][nb_] = *(const bf16x8*)(brp + (nb_) * 32 * 72 + (ks_) * 16)
#define MM(ks_, nb_) do { acc[0][nb_] = MFMA(fa[ks_][0], fb[ks_][nb_], acc[0][nb_]); acc[1][nb_] = MFMA(fa[ks_][1], fb[ks_][nb_], acc[1][nb_]); } while (0)
#define SB() __builtin_amdgcn_sched_barrier(0)
#define COMPUTE() do { bf16x8 fa[4][2], fb[4][4]; const u16* arp = &As[(w * 64 + r) * 72 + h * 8]; const u16* brp = &Bs[r * 72 + h * 8]; \
        RDA(0); RDB(0, 0); RDB(0, 1); SB(); \
        RDB(0, 2); SB(); MM(0, 0); SB(); \
        RDB(0, 3); SB(); MM(0, 1); SB(); \
        RDA(1); RDB(1, 0); SB(); MM(0, 2); SB(); \
        RDB(1, 1); SB(); MM(0, 3); SB(); \
        RDB(1, 2); SB(); MM(1, 0); SB(); \
        RDB(1, 3); SB(); MM(1, 1); SB(); \
        RDA(2); RDB(2, 0); SB(); MM(1, 2); SB(); \
        RDB(2, 1); SB(); MM(1, 3); SB(); \
        RDB(2, 2); SB(); MM(2, 0); SB(); \
        RDB(2, 3); SB(); MM(2, 1); SB(); \
        RDA(3); RDB(3, 0); SB(); MM(2, 2); SB(); \
        RDB(3, 1); SB(); MM(2, 3); SB(); \
        RDB(3, 2); SB(); MM(3, 0); SB(); \
        RDB(3, 3); SB(); MM(3, 1); SB(); \
        SB(); MM(3, 2); SB(); \
        SB(); MM(3, 3); SB(); } while (0)
    const int nk = g.K >> 6;
    GLOAD(0);
    __syncthreads();
    SSTORE();
    __syncthreads();
#pragma unroll 1
    for (int kt = 0; kt < nk; ++kt) {
        if (kt + 1 < nk) GLOAD((kt + 1) << 6);
        COMPUTE();
        __syncthreads();
        if (kt + 1 < nk) { SSTORE(); __syncthreads(); }
    }
#undef GLOAD
#undef SSTORE
#undef COMPUTE
#undef RDA
#undef RDB
#undef MM
#undef SB
    size_t wsoff_ = 0; asm volatile("" : "+s"(wsoff_)); char* ws = p.ws + wsoff_;
    const int rbase = g.m0 + w * 64;
    switch (g.emode) {
    case E_QDUAL: case E_ROPE: case E_RK: {
        const float2* tab = (const float2*)(ws + WS_ROPE);
        const float sc = (g.emode == E_RK) ? SC128 : 1.f;
        u16* dst = (u16*)g.dst;
        const int ld = g.e0, co = g.e1;
        float log2g = 0.f;
        if (g.emode == E_RK) log2g = log2f(1.f - exp2f(-5.f - (float)(co >> 7)));
        u16* dT = (u16*)(ws + WS_RKZT); const int head = co >> 7;
        u16* qn = (u16*)(ws + WS_QN);
#pragma unroll
        for (int mb = 0; mb < 2; ++mb)
#pragma unroll
            for (int a = 0; a < 4; ++a) {
                const int row0 = rbase + mb * 32 + 8 * a + 4 * h; const int b = row0 >> 11, s0 = row0 & 2047;
                float z[4] = {1.f, 1.f, 1.f, 1.f};
                if (g.emode == E_RK) {
#pragma unroll
                    for (int c = 0; c < 4; ++c) z[c] = exp2f((float)(127 - ((s0 + c) & 127)) * log2g);
                }
#pragma unroll
                for (int nb = 0; nb < 2; ++nb) {
                    const int d = nb * 32 + r;
                    float o1[4], o2[4];
#pragma unroll
                    for (int c = 0; c < 4; ++c) {
                        const int i = 4 * a + c; const int row = row0 + c;
                        float2 cs = tab[(s0 + c) * 64 + d];
                        float x1 = acc[mb][nb][i], x2 = acc[mb][nb + 2][i];
                        o1[c] = (x1 * cs.x - x2 * cs.y) * sc; o2[c] = (x1 * cs.y + x2 * cs.x) * sc;
                        if (g.emode == E_QDUAL) { qn[(size_t)row * ld + co + d] = f2bf(x1); qn[(size_t)row * ld + co + d + 64] = f2bf(x2); }
                        dst[(size_t)row * ld + co + d] = f2bf(o1[c]); dst[(size_t)row * ld + co + d + 64] = f2bf(o2[c]);
                    }
                    if (g.emode == E_RK) {
                        u32x2 v; v[0] = pk2(o1[0] * z[0], o1[1] * z[1]); v[1] = pk2(o1[2] * z[2], o1[3] * z[3]);
                        *(u32x2*)&dT[((size_t)(b * 8 + head) * 128 + d) * 2048 + s0] = v;
                        v[0] = pk2(o2[0] * z[0], o2[1] * z[1]); v[1] = pk2(o2[2] * z[2], o2[3] * z[3]);
                        *(u32x2*)&dT[((size_t)(b * 8 + head) * 128 + d + 64) * 2048 + s0] = v;
                    }
                }
                __builtin_amdgcn_sched_barrier(0);
            }
    } break;
    case E_PLAIN: case E_SILU: {
        u16* dst = (u16*)g.dst; const int ld = g.e0, co = g.e1;
#pragma unroll
        for (int mb = 0; mb < 2; ++mb)
#pragma unroll
            for (int i = 0; i < 16; ++i) {
                const int row = rbase + mb * 32 + crow(i, h);
                if (row < g.M) {
#pragma unroll
                    for (int nb = 0; nb < 4; ++nb) {
                        float v = acc[mb][nb][i];
                        if (g.emode == E_SILU) v = v / (1.f + __expf(-v));
                        dst[(size_t)row * ld + co + nb * 32 + r] = f2bf(v);
                    }
                }
            }
    } break;
    case E_VT: {
        u16* dT = (u16*)g.dst; const int nh = g.e0, head = g.e1;
#pragma unroll
        for (int mb = 0; mb < 2; ++mb)
#pragma unroll
            for (int a = 0; a < 4; ++a) {
                const int row0 = rbase + mb * 32 + 8 * a + 4 * h; const int b = row0 >> 11, s0 = row0 & 2047;
#pragma unroll
                for (int nb = 0; nb < 4; ++nb) {
                    const int d = nb * 32 + r;
                    u32x2 v; v[0] = pk2(acc[mb][nb][4 * a], acc[mb][nb][4 * a + 1]); v[1] = pk2(acc[mb][nb][4 * a + 2], acc[mb][nb][4 * a + 3]);
                    *(u32x2*)&dT[((size_t)(b * nh + head) * 128 + d) * 2048 + s0] = v;
                }
            }
    } break;
    case E_XVT: {
        u16* dT = (u16*)g.dst; const int head = g.e1 >> 9, d0 = g.e1 & 511;
#pragma unroll
        for (int mb = 0; mb < 2; ++mb)
#pragma unroll
            for (int a = 0; a < 4; ++a) {
                const int row0 = rbase + mb * 32 + 8 * a + 4 * h; const int b = row0 >> 8, m = row0 & 255;
#pragma unroll
                for (int nb = 0; nb < 4; ++nb) {
                    const int d = d0 + nb * 32 + r;
                    u32x2 v; v[0] = pk2(acc[mb][nb][4 * a], acc[mb][nb][4 * a + 1]); v[1] = pk2(acc[mb][nb][4 * a + 2], acc[mb][nb][4 * a + 3]);
                    *(u32x2*)&dT[((size_t)(b * 4 + head) * 512 + d) * 256 + m] = v;
                }
            }
    } break;
    case E_GATE: {
        float* dst = (float*)(ws + WS_GATES); const float* bg = lnd(p.in[I_BGATE]) + L * 24;
        if (r < 24) {
            const float bias = bg[r];
#pragma unroll
            for (int mb = 0; mb < 2; ++mb)
#pragma unroll
                for (int i = 0; i < 16; ++i) {
                    const int row = rbase + mb * 32 + crow(i, h);
                    float v = acc[mb][0][i] + bias;
                    dst[(size_t)row * 24 + r] = 1.f / (1.f + __expf(-v));
                }
        }
    } break;
    case E_RESID: {
        float* y = (float*)(ws + WS_Y); const float* xr = g.aux; const int co = g.e1;
#pragma unroll
        for (int mb = 0; mb < 2; ++mb)
#pragma unroll
            for (int i = 0; i < 16; ++i) {
                const int row = rbase + mb * 32 + crow(i, h);
#pragma unroll
                for (int nb = 0; nb < 4; ++nb) { size_t ix = (size_t)row * 2048 + co + nb * 32 + r; y[ix] = ALPHA * xr[ix] + acc[mb][nb][i]; }
            }
    } break;
    case E_F32: {
        float* dst = (float*)g.dst; const int ld = g.e0, co = g.e1;
#pragma unroll
        for (int mb = 0; mb < 2; ++mb)
#pragma unroll
            for (int i = 0; i < 16; ++i) {
                const int row = rbase + mb * 32 + crow(i, h);
#pragma unroll
                for (int nb = 0; nb < 4; ++nb) dst[(size_t)row * ld + co + nb * 32 + r] = acc[mb][nb][i];
            }
    } break;
    }
}

DI void inproj_desc(const P& p, int L, int nt, int mt, GT& g) {
    size_t wsoff_ = 0; asm volatile("" : "+s"(wsoff_)); char* ws = p.ws + wsoff_;
    g.A = (const u16*)(ws + WS_XB); g.lda = 2048; g.amode = 0; g.kbeg = 0; g.M = T; g.m0 = mt * 256; g.ldb = 2048; g.K = 2048; g.ncols = 128; g.aux = nullptr;
    const u16* W = (const u16*)(ws + WS_WT) + (size_t)L * WT_LAYER + WT_IN;
    int col0;
    if (nt < 8) { col0 = nt * 128; g.emode = E_QDUAL; g.dst = ws + WS_QR; g.e0 = 1024; g.e1 = nt * 128; }
    else if (nt < 10) { int q = nt - 8; col0 = 1024 + q * 128; g.emode = E_PLAIN; g.dst = ws + WS_KC; g.e0 = 256; g.e1 = q * 128; }
    else if (nt < 12) { int q = nt - 10; col0 = 1280 + q * 128; g.emode = E_PLAIN; g.dst = ws + WS_VC; g.e0 = 256; g.e1 = q * 128; }
    else if (nt < 14) { int q = nt - 12; col0 = 1536 + q * 128; g.emode = E_ROPE; g.dst = ws + WS_KS; g.e0 = 256; g.e1 = q * 128; }
    else if (nt < 16) { int q = nt - 14; col0 = 1792 + q * 128; g.emode = E_VT; g.dst = ws + WS_VST; g.e0 = 2; g.e1 = q; }
    else if (nt < 18) { int q = nt - 16; col0 = 2048 + q * 128; g.emode = E_ROPE; g.dst = ws + WS_KW; g.e0 = 256; g.e1 = q * 128; }
    else if (nt < 20) { int q = nt - 18; col0 = 2304 + q * 128; g.emode = E_VT; g.dst = ws + WS_VWT; g.e0 = 2; g.e1 = q; }
    else if (nt == 20) { col0 = 2560; g.emode = E_GATE; g.ncols = 24; g.dst = nullptr; g.e0 = 0; g.e1 = 0; }
    else if (nt < 29) { int q = nt - 21; col0 = 2584 + q * 128; g.emode = E_ROPE; g.dst = ws + WS_RQ; g.e0 = 1024; g.e1 = q * 128; }
    else if (nt < 37) { int q = nt - 29; col0 = 3608 + q * 128; g.emode = E_RK; g.dst = ws + WS_RK; g.e0 = 1024; g.e1 = q * 128; }
    else if (nt < 45) { int q = nt - 37; col0 = 4632 + q * 128; g.emode = E_VT; g.dst = ws + WS_RVT; g.e0 = 8; g.e1 = q; }
    else { int q = nt - 45; col0 = 5656 + q * 128; g.emode = E_SILU; g.dst = ws + WS_RGS; g.e0 = 1024; g.e1 = q * 128; }
    g.B = W + (size_t)col0 * 2048;
}

template <int MODE>
DI void attn_item(const P& p, int it, char* smem) {
    size_t wsoff_ = 0; asm volatile("" : "+s"(wsoff_)); char* ws = p.ws + wsoff_;
    const int lane = TID() & 63, w = TID() >> 6, r = lane & 31, h = lane >> 5;
    const int b = it >> 7, g = (it >> 6) & 1, qb = it & 63, q0 = qb * 32;
    const int hq = g * 4 + w;
    const u16* Q = (const u16*)(ws + WS_QR);
    const u16* K = (const u16*)(ws + (MODE == 0 ? WS_KW : WS_KS));
    const u16* VT = (const u16*)(ws + (MODE == 0 ? WS_VWT : WS_VST)) + (size_t)(b * 2 + g) * 128 * 2048;
    const int qpos = q0 + r;
    const size_t tq = (size_t)b * 2048 + qpos;
    bf16x8 qf[8];
#pragma unroll
    for (int ks = 0; ks < 8; ++ks) qf[ks] = ldfrag(Q + tq * 1024 + hq * 128 + ks * 16 + h * 8);
    unsigned selm = 0xffffffffu, um = 0xffffffffu;
    if (MODE == 1) {
        selm = ((const unsigned*)(ws + WS_SEL))[(size_t)(b * 2 + g) * 2048 + qpos];
        um = selm;
        for (int o = 1; o <= 16; o <<= 1) um |= __shfl_xor(um, o);
    }
    f32x16 o[4];
#pragma unroll
    for (int db = 0; db < 4; ++db) o[db] = zero16();
    float m = NEG, l = 0.f;
    unsigned tmask;
    {
        const int cur = q0 >> 6;
        const unsigned upto = (cur == 31) ? 0xffffffffu : ((1u << (cur + 1)) - 1u);
        if (MODE == 0) { int lo = q0 - 512; if (lo < 0) lo = 0; lo >>= 6; tmask = upto & ~((1u << lo) - 1u); }
        else tmask = (unsigned)__builtin_amdgcn_readfirstlane((int)um) & upto;
    }
    u16* Ks = (u16*)smem;
    u16* Vs = (u16*)(smem + 17408);
    const int tid = TID();
    const u16* Kg = K + ((size_t)b * 2048 + (tid >> 4)) * 256 + g * 128 + (tid & 15) * 8;
    const u16* Vg = VT + (size_t)(tid >> 3) * 2048 + (tid & 7) * 8;
    u32x4 kr0, kr1, kr2, kr3, vr0, vr1, vr2, vr3;
#define ALOAD(tile_) do { const u16* kq_ = Kg + (size_t)(tile_) * 64 * 256; const u16* vq_ = Vg + (tile_) * 64; \
        kr0 = *(const u32x4*)(kq_); kr1 = *(const u32x4*)(kq_ + 16 * 256); kr2 = *(const u32x4*)(kq_ + 32 * 256); kr3 = *(const u32x4*)(kq_ + 48 * 256); \
        vr0 = *(const u32x4*)(vq_); vr1 = *(const u32x4*)(vq_ + 32 * 2048); vr2 = *(const u32x4*)(vq_ + 64 * 2048); vr3 = *(const u32x4*)(vq_ + 96 * 2048); } while (0)
#define ASTORE() do { u16* kd_ = Ks + (tid >> 4) * 136 + (tid & 15) * 8; u16* vd_ = Vs + (tid >> 3) * 72 + (tid & 7) * 8; \
        *(u32x4*)(kd_) = kr0; *(u32x4*)(kd_ + 16 * 136) = kr1; *(u32x4*)(kd_ + 32 * 136) = kr2; *(u32x4*)(kd_ + 48 * 136) = kr3; \
        *(u32x4*)(vd_) = vr0; *(u32x4*)(vd_ + 32 * 72) = vr1; *(u32x4*)(vd_ + 64 * 72) = vr2; *(u32x4*)(vd_ + 96 * 72) = vr3; } while (0)
    int tile = __builtin_ctz(tmask); tmask &= tmask - 1u;
    ALOAD(tile);
    __syncthreads();
    ASTORE();
    __syncthreads();
    for (;;) {
        const bool more = tmask != 0u;
        const int ntile = more ? __builtin_ctz(tmask) : tile;
        tmask &= tmask - 1u;
        if (more) ALOAD(ntile);
        const bool full = (MODE == 0) ? ((tile * 64 + 63 <= q0) && ((q0 + 31) - tile * 64 < 512)) : (tile * 64 + 63 <= q0);
        const bool selbit = (MODE == 1) ? (((selm >> tile) & 1u) != 0u) : true;
#pragma unroll
        for (int sub = 0; sub < 2; ++sub) {
            const int kp0 = tile * 64 + sub * 32;
            if (kp0 > q0 + 31) continue;
            f32x16 s = zero16();
#pragma unroll
            for (int ks = 0; ks < 8; ++ks) s = MFMA(*(const bf16x8*)&Ks[(sub * 32 + r) * 136 + ks * 16 + h * 8], qf[ks], s);
            constexpr float C2 = 0.12751743074602467f;
            float pv[16];
            float mx = NEG;
            float ps = 0.f;
            float mn, corr;
            const float m_old = m;
            if (full) {
#pragma unroll
                for (int i = 0; i < 16; ++i) { const float t = s[i] * C2; pv[i] = t; mx = fmaxf(mx, t); }
                if (MODE == 1) mx = selbit ? mx : NEG;
                mx = fmaxf(mx, __shfl_xor(mx, 32));
                mn = fmaxf(m, mx);
                corr = __builtin_amdgcn_exp2f(m - mn);
#pragma unroll
                for (int i = 0; i < 16; ++i) { float e = __builtin_amdgcn_exp2f(pv[i] - mn); if (MODE == 1) e = selbit ? e : 0.f; pv[i] = e; ps += e; }
            } else {
                bool okv[16];
#pragma unroll
                for (int i = 0; i < 16; ++i) {
                    const int key = kp0 + crow(i, h);
                    bool ok = key <= qpos;
                    if (MODE == 0) ok = ok && (qpos - key < 512);
                    else ok = ok && selbit;
                    okv[i] = ok;
                    const float t = ok ? s[i] * C2 : NEG;
                    pv[i] = t; mx = fmaxf(mx, t);
                }
                mx = fmaxf(mx, __shfl_xor(mx, 32));
                mn = fmaxf(m, mx);
                corr = __builtin_amdgcn_exp2f(m - mn);
#pragma unroll
                for (int i = 0; i < 16; ++i) { float e = okv[i] ? __builtin_amdgcn_exp2f(pv[i] - mn) : 0.f; pv[i] = e; ps += e; }
            }
            l = l * corr + ps; m = mn;
            if (__builtin_amdgcn_ballot_w64(mn > m_old) != 0ull) {
#pragma unroll
                for (int db = 0; db < 4; ++db)
#pragma unroll
                    for (int i = 0; i < 16; ++i) o[db][i] *= corr;
            }
            bf16x8 pf0 = pack8(pv[0], pv[1], pv[2], pv[3], pv[4], pv[5], pv[6], pv[7]);
            bf16x8 pf1 = pack8(pv[8], pv[9], pv[10], pv[11], pv[12], pv[13], pv[14], pv[15]);
#pragma unroll
            for (int db = 0; db < 4; ++db) {
                const u16* vp = Vs + (db * 32 + r) * 72 + sub * 32 + 4 * h;
                o[db] = MFMA(ld2x8(vp, vp + 8), pf0, o[db]);
                o[db] = MFMA(ld2x8(vp + 16, vp + 24), pf1, o[db]);
            }
        }
        if (!more) break;
        __syncthreads();
        ASTORE();
        __syncthreads();
        tile = ntile;
    }
#undef ALOAD
#undef ASTORE
    l += __shfl_xor(l, 32);
    const float inv = 1.f / l;
    const float* gates = (const float*)(ws + WS_GATES);
    const float gt = gates[tq * 24 + hq * 3 + (MODE == 0 ? 2 : 1)] * inv;
    float* onsa = (float*)(ws + WS_ONSA);
    u16* mix = (u16*)(ws + WS_MIX);
#pragma unroll
    for (int db = 0; db < 4; ++db)
#pragma unroll
        for (int a = 0; a < 4; ++a) {
            const int d = db * 32 + 8 * a + 4 * h;
            float4* op = (float4*)&onsa[tq * 1024 + hq * 128 + d];
            float4 v = make_float4(o[db][4 * a] * gt, o[db][4 * a + 1] * gt, o[db][4 * a + 2] * gt, o[db][4 * a + 3] * gt);
            if (MODE == 0) *op = v;
            else {
                float4 pr = *op;
                float4 pc = *(const float4*)((const float*)(ws + WS_OC) + tq * 1024 + hq * 128 + d);
                u32x2 ov; ov[0] = pk2(pr.x + pc.x + v.x, pr.y + pc.y + v.y); ov[1] = pk2(pr.z + pc.z + v.z, pr.w + pc.w + v.w);
                *(u32x2*)&mix[tq * 2048 + hq * 128 + d] = ov;
            }
        }
}

DI void cmp_item(const P& p, int it, char* smem) {
    size_t wsoff_ = 0; asm volatile("" : "+s"(wsoff_)); char* ws = p.ws + wsoff_;
    const int tid = TID(), lane = tid & 63, w = tid >> 6, r = lane & 31, h = lane >> 5;
    const int b = it >> 7, g = (it >> 6) & 1, qb = it & 63, q0 = qb * 32;
    const int hq = g * 4 + w;
    const u16* Q = (const u16*)(ws + WS_QN);
    const u16* K = (const u16*)(ws + WS_KCMP) + (size_t)(b * 2 + g) * 128 * 128;
    const u16* VT = (const u16*)(ws + WS_VCMPT) + (size_t)(b * 2 + g) * 128 * 128;
    const int qpos = q0 + r;
    const size_t tq = (size_t)b * 2048 + qpos;
    float* impb = (float*)smem;
    float* scb = (float*)(smem + 16384);
    __syncthreads();
    bf16x8 qf[8];
#pragma unroll
    for (int ks = 0; ks < 8; ++ks) qf[ks] = ldfrag(Q + tq * 1024 + hq * 128 + ks * 16 + h * 8);
    f32x16 s[4];
    float mx = NEG;
#pragma unroll
    for (int kb = 0; kb < 4; ++kb) {
        s[kb] = zero16();
        const u16* kp = K + (size_t)(kb * 32 + r) * 128 + h * 8;
#pragma unroll
        for (int ks = 0; ks < 8; ++ks) s[kb] = MFMA(ldfrag(kp + ks * 16), qf[ks], s[kb]);
#pragma unroll
        for (int i = 0; i < 16; ++i) {
            const int n = kb * 32 + crow(i, h);
            const bool vis = (n < 127) && (16 * n + 31 <= qpos);
            float v = vis ? s[kb][i] * SC128 : NEG;
            s[kb][i] = v; mx = fmaxf(mx, v);
        }
    }
    mx = fmaxf(mx, __shfl_xor(mx, 32));
    float sum = 0.f;
#pragma unroll
    for (int kb = 0; kb < 4; ++kb)
#pragma unroll
        for (int i = 0; i < 16; ++i) {
            const int n = kb * 32 + crow(i, h);
            const bool vis = (n < 127) && (16 * n + 31 <= qpos);
            float e = vis ? __expf(s[kb][i] - mx) : 0.f;
            s[kb][i] = e; sum += e;
        }
    sum += __shfl_xor(sum, 32);
    const float inv = sum > 0.f ? 1.f / sum : 0.f;
#pragma unroll
    for (int kb = 0; kb < 4; ++kb)
#pragma unroll
        for (int i = 0; i < 16; ++i) s[kb][i] *= inv;
    {
        float G[4][4], lastp[4][4];
#pragma unroll
        for (int kb = 0; kb < 4; ++kb)
#pragma unroll
            for (int a = 0; a < 4; ++a) {
                G[kb][a] = s[kb][4 * a] + s[kb][4 * a + 1] + s[kb][4 * a + 2] + s[kb][4 * a + 3];
                lastp[kb][a] = __shfl_xor(s[kb][4 * a + 3], 32);
            }
#pragma unroll
        for (int kb = 0; kb < 4; ++kb)
#pragma unroll
            for (int a = 0; a < 4; ++a) {
                const int j = 8 * kb + 2 * a + h;
                float prevl;
                if (a > 0) prevl = lastp[kb][a - 1]; else if (kb > 0) prevl = lastp[kb - 1][3]; else prevl = 0.f;
                float add = h ? lastp[kb][a] : prevl;
                impb[(w * 32 + r) * 32 + j] = G[kb][a] + add;
            }
    }
    __builtin_amdgcn_sched_barrier(0);
    f32x16 o[4];
#pragma unroll
    for (int db = 0; db < 4; ++db) o[db] = zero16();
#pragma unroll
    for (int kb = 0; kb < 4; ++kb) {
        __builtin_amdgcn_sched_barrier(0);
        bf16x8 pf0 = pack8(s[kb][0], s[kb][1], s[kb][2], s[kb][3], s[kb][4], s[kb][5], s[kb][6], s[kb][7]);
        bf16x8 pf1 = pack8(s[kb][8], s[kb][9], s[kb][10], s[kb][11], s[kb][12], s[kb][13], s[kb][14], s[kb][15]);
#pragma unroll
        for (int db = 0; db < 4; ++db) {
            const u16* vp = VT + (size_t)(db * 32 + r) * 128 + kb * 32 + 4 * h;
            o[db] = MFMA(ld2x8(vp, vp + 8), pf0, o[db]);
            o[db] = MFMA(ld2x8(vp + 16, vp + 24), pf1, o[db]);
        }
    }
    {
        const float* gates = (const float*)(ws + WS_GATES);
        const float gt = gates[tq * 24 + hq * 3 + 0];
        float* onsa = (float*)(ws + WS_OC);
#pragma unroll
        for (int db = 0; db < 4; ++db)
#pragma unroll
            for (int a = 0; a < 4; ++a) {
                const int d = db * 32 + 8 * a + 4 * h;
                float4* op = (float4*)&onsa[tq * 1024 + hq * 128 + d];
                float4 pr;
                pr.x = o[db][4 * a] * gt; pr.y = o[db][4 * a + 1] * gt; pr.z = o[db][4 * a + 2] * gt; pr.w = o[db][4 * a + 3] * gt;
                *op = pr;
            }
    }
    __syncthreads();
    unsigned* selo = (unsigned*)(ws + WS_SEL) + (size_t)(b * 2 + g) * 2048;
#pragma unroll
    for (int itq = 0; itq < 4; ++itq) {
        const int q = w * 8 + itq * 2 + h;
        const int t = q0 + q, cur = t >> 6, j = r;
        float sc = impb[(0 * 32 + q) * 32 + j] + impb[(1 * 32 + q) * 32 + j] + impb[(2 * 32 + q) * 32 + j] + impb[(3 * 32 + q) * 32 + j];
        const bool forced = (j == 0) || (j == cur) || (j == cur - 1);
        if (forced) sc = 1e9f;
        if (!(j * 64 <= t)) sc = -1.f;
        scb[q * 32 + j] = sc;
        CBAR();
        int cnt = 0;
#pragma unroll
        for (int j2 = 0; j2 < 32; j2 += 4) {
            float4 x = *(const float4*)&scb[q * 32 + j2];
            cnt += (x.x > sc) || (x.x == sc && (j2 + 0) < j);
            cnt += (x.y > sc) || (x.y == sc && (j2 + 1) < j);
            cnt += (x.z > sc) || (x.z == sc && (j2 + 2) < j);
            cnt += (x.w > sc) || (x.w == sc && (j2 + 3) < j);
        }
        unsigned long long bal = __ballot(cnt < 16);
        unsigned mk = h ? (unsigned)(bal >> 32) : (unsigned)bal;
        if (r == 0) selo[t] = mk;
    }
}

DI void retstate_item(const P& p, int it) {
    size_t wsoff_ = 0; asm volatile("" : "+s"(wsoff_)); char* ws = p.ws + wsoff_;
    const int lane = TID() & 63, w = TID() >> 6, r = lane & 31, h = lane >> 5;
    const int c = it & 15, bh = it >> 4;
    const u16* VT = (const u16*)(ws + WS_RVT) + (size_t)bh * 128 * 2048 + c * 128;
    const u16* KT = (const u16*)(ws + WS_RKZT) + (size_t)bh * 128 * 2048 + c * 128;
    f32x16 acc[4];
#pragma unroll
    for (int db = 0; db < 4; ++db) acc[db] = zero16();
#pragma unroll
    for (int ks = 0; ks < 8; ++ks) {
        bf16x8 a = ldfrag(VT + (size_t)(w * 32 + r) * 2048 + ks * 16 + h * 8);
#pragma unroll
        for (int db = 0; db < 4; ++db) acc[db] = MFMA(a, ldfrag(KT + (size_t)(db * 32 + r) * 2048 + ks * 16 + h * 8), acc[db]);
    }
    float* dst = (float*)(ws + WS_SST) + (size_t)it * 128 * 128;
#pragma unroll
    for (int db = 0; db < 4; ++db)
#pragma unroll
        for (int i = 0; i < 16; ++i) dst[(w * 32 + crow(i, h)) * 128 + db * 32 + r] = acc[db][i];
}

DI void cmpfin_item(const P& p, int L, int it, char* smem) {
    size_t wsoff_ = 0; asm volatile("" : "+s"(wsoff_)); char* ws = p.ws + wsoff_;
    const int tid = TID();
    const int i = it >> 7, r0 = (it & 127) * 8;
    float* biasS = (float*)smem;
    float* hS = (float*)(smem + 512);
    __syncthreads();
    if (tid < 128) {
        const float* pb = (const float*)(ws + WS_POSB) + (size_t)(L * 2 + i) * 64 * 128;
        float sacc = 0.f;
#pragma unroll 8
        for (int q = 0; q < 64; ++q) sacc += pb[q * 128 + tid];
        biasS[tid] = sacc;
    }
    __syncthreads();
    {
        const int row = tid >> 5, k4 = (tid & 31) * 4;
        const float* part = (const float*)(ws + WS_CPART) + (size_t)(i * 8) * 1024 * 128 + (size_t)(r0 + row) * 128 + k4;
        float4 a = make_float4(0.f, 0.f, 0.f, 0.f);
#pragma unroll
        for (int ksp = 0; ksp < 8; ++ksp) { float4 x = *(const float4*)(part + (size_t)ksp * 1024 * 128); a.x += x.x; a.y += x.y; a.z += x.z; a.w += x.w; }
        hS[row * 128 + k4 + 0] = gelu_erf(a.x + biasS[k4 + 0]); hS[row * 128 + k4 + 1] = gelu_erf(a.y + biasS[k4 + 1]);
        hS[row * 128 + k4 + 2] = gelu_erf(a.z + biasS[k4 + 2]); hS[row * 128 + k4 + 3] = gelu_erf(a.w + biasS[k4 + 3]);
    }
    __syncthreads();
    {
        const int n = tid & 127, rh = tid >> 7;
        const float* w2 = lnd(p.in[I_CW2]) + (size_t)(L * 2 + i) * 128 * 128;
        float acc0 = 0.f, acc1 = 0.f, acc2 = 0.f, acc3 = 0.f;
#pragma unroll 8
        for (int k = 0; k < 128; ++k) {
            const float wv = w2[k * 128 + n];
            acc0 += hS[(rh * 4 + 0) * 128 + k] * wv; acc1 += hS[(rh * 4 + 1) * 128 + k] * wv;
            acc2 += hS[(rh * 4 + 2) * 128 + k] * wv; acc3 += hS[(rh * 4 + 3) * 128 + k] * wv;
        }
        u16* kc = (u16*)(ws + WS_KCMP); u16* vt = (u16*)(ws + WS_VCMPT);
        float accs[4] = {acc0, acc1, acc2, acc3};
#pragma unroll
        for (int j = 0; j < 4; ++j) {
            const int row = r0 + rh * 4 + j;
            const int b = row >> 8, nn = (row >> 1) & 127, gg = row & 1;
            const u16 v = (nn == 127) ? (u16)0 : f2bf(accs[j]);
            if (i == 0) kc[((size_t)(b * 2 + gg) * 128 + nn) * 128 + n] = v;
            else vt[((size_t)(b * 2 + gg) * 128 + n) * 128 + nn] = v;
        }
    }
}

DI void retscan_item(const P& p, int it) {
    size_t wsoff_ = 0; asm volatile("" : "+s"(wsoff_)); char* ws = p.ws + wsoff_;
    const int tid = TID();
    const int eb = it & 15, bh = it >> 4, hh = bh & 7;
    const float log2g = log2f(1.f - exp2f(-5.f - (float)hh));
    const float cdec = exp2f(128.f * log2g);
    const int e = eb * 1024 + tid * 4;
    const float* sb = (const float*)(ws + WS_SST) + (size_t)(bh * 16) * 16384 + e;
    u16* rb = (u16*)(ws + WS_RBUF) + (size_t)(bh * 16) * 16384 + e;
    float4 x[15];
#pragma unroll
    for (int c = 0; c < 15; ++c) x[c] = *(const float4*)(sb + (size_t)c * 16384);
    float4 R = make_float4(0.f, 0.f, 0.f, 0.f);
    u32x2 z; z[0] = 0u; z[1] = 0u;
    *(u32x2*)rb = z;
#pragma unroll
    for (int c = 0; c < 15; ++c) {
        R.x = R.x * cdec + x[c].x; R.y = R.y * cdec + x[c].y; R.z = R.z * cdec + x[c].z; R.w = R.w * cdec + x[c].w;
        u32x2 pk; pk[0] = pk2(R.x, R.y); pk[1] = pk2(R.z, R.w);
        *(u32x2*)(rb + (size_t)(c + 1) * 16384) = pk;
    }
}

DI void retout_item(const P& p, int L, int it, char* smem) {
    size_t wsoff_ = 0; asm volatile("" : "+s"(wsoff_)); char* ws = p.ws + wsoff_;
    const int tid = TID(), lane = tid & 63, w = tid >> 6, r = lane & 31, h = lane >> 5;
    const int c = it & 15, bh = it >> 4, hh = bh & 7, b = bh >> 3;
    const float log2g = log2f(1.f - exp2f(-5.f - (float)hh));
    const float cdec = exp2f(128.f * log2g);
    const u16* Rt = (const u16*)(ws + WS_RBUF) + (size_t)(bh * 16 + c) * 16384;
    const int i0 = w * 32, iq = i0 + r;
    const size_t tq = (size_t)b * 2048 + c * 128 + iq;
    const u16* Q = (const u16*)(ws + WS_RQ);
    const u16* K = (const u16*)(ws + WS_RK);
    const u16* VT = (const u16*)(ws + WS_RVT) + (size_t)bh * 128 * 2048 + c * 128;
    bf16x8 qf[8];
#pragma unroll
    for (int ks = 0; ks < 8; ++ks) qf[ks] = ldfrag(Q + tq * 1024 + hh * 128 + ks * 16 + h * 8);
    f32x16 o[4];
#pragma unroll
    for (int vb = 0; vb < 4; ++vb) {
        o[vb] = zero16();
#pragma unroll
        for (int ks = 0; ks < 8; ++ks) o[vb] = MFMA(ldfrag(Rt + (vb * 32 + r) * 128 + ks * 16 + h * 8), qf[ks], o[vb]);
    }
    const float xi = exp2f((float)(iq + 1) * log2g);
#pragma unroll
    for (int vb = 0; vb < 4; ++vb)
#pragma unroll
        for (int i = 0; i < 16; ++i) o[vb][i] *= xi;
    for (int jb = 0; jb <= w; ++jb) {
        f32x16 s = zero16();
        const u16* kp = K + ((size_t)b * 2048 + c * 128 + jb * 32 + r) * 1024 + hh * 128 + h * 8;
#pragma unroll
        for (int ks = 0; ks < 8; ++ks) s = MFMA(ldfrag(kp + ks * 16), qf[ks], s);
        float pv[16];
#pragma unroll
        for (int i = 0; i < 16; ++i) {
            const int j = jb * 32 + crow(i, h);
            const int df = iq - j;
            pv[i] = (df >= 0) ? s[i] * exp2f((float)df * log2g) : 0.f;
        }
        bf16x8 pf0 = pack8(pv[0], pv[1], pv[2], pv[3], pv[4], pv[5], pv[6], pv[7]);
        bf16x8 pf1 = pack8(pv[8], pv[9], pv[10], pv[11], pv[12], pv[13], pv[14], pv[15]);
#pragma unroll
        for (int vb = 0; vb < 4; ++vb) {
            const u16* vp = VT + (size_t)(vb * 32 + r) * 2048 + jb * 32 + 4 * h;
            o[vb] = MFMA(ld2x8(vp, vp + 8), pf0, o[vb]);
            o[vb] = MFMA(ld2x8(vp + 16, vp + 24), pf1, o[vb]);
        }
    }
    float sm = 0.f;
#pragma unroll
    for (int vb = 0; vb < 4; ++vb)
#pragma unroll
        for (int i = 0; i < 16; ++i) sm += o[vb][i];
    sm += __shfl_xor(sm, 32);
    const float mu = sm * (1.f / 128.f);
    float vs = 0.f;
#pragma unroll
    for (int vb = 0; vb < 4; ++vb)
#pragma unroll
        for (int i = 0; i < 16; ++i) { float dlt = o[vb][i] - mu; vs += dlt * dlt; }
    vs += __shfl_xor(vs, 32);
    const float rs = rsqrtf(vs * (1.f / 128.f) + 1e-5f);
    const float* gg = lnd(p.in[I_GNG]) + L * 1024 + hh * 128;
    const float* gb = lnd(p.in[I_GNB]) + L * 1024 + hh * 128;
    const u16* rgs = (const u16*)(ws + WS_RGS) + tq * 1024 + hh * 128;
    u16* mix = (u16*)(ws + WS_MIX) + tq * 2048 + 1024 + hh * 128;
#pragma unroll
    for (int vb = 0; vb < 4; ++vb)
#pragma unroll
        for (int a = 0; a < 4; ++a) {
            const int v0 = vb * 32 + 8 * a + 4 * h;
            float4 g4 = *(const float4*)&gg[v0], b4 = *(const float4*)&gb[v0];
            u32x2 gt = *(const u32x2*)&rgs[v0];
            float y0 = ((o[vb][4 * a] - mu) * rs * g4.x + b4.x) * bflo(gt[0]);
            float y1 = ((o[vb][4 * a + 1] - mu) * rs * g4.y + b4.y) * bfhi(gt[0]);
            float y2 = ((o[vb][4 * a + 2] - mu) * rs * g4.z + b4.z) * bflo(gt[1]);
            float y3 = ((o[vb][4 * a + 3] - mu) * rs * g4.w + b4.w) * bfhi(gt[1]);
            u32x2 ov; ov[0] = pk2(y0, y1); ov[1] = pk2(y2, y3);
            *(u32x2*)&mix[v0] = ov;
        }
}

DI void xattn_item(const P& p, int it, char* smem) {
    size_t wsoff_ = 0; asm volatile("" : "+s"(wsoff_)); char* ws = p.ws + wsoff_;
    const int tid = TID(), lane = tid & 63, w = tid >> 6, r = lane & 31, h = lane >> 5;
    const int qb = it & 31, head = (it >> 5) & 3, b = it >> 7;
    const size_t t0 = (size_t)b * 2048 + qb * 64;
    const u16* Qg = (const u16*)(ws + WS_XQ) + t0 * 2048 + head * 512;
    const u16* Kg = (const u16*)(ws + WS_XK) + (size_t)(b * 256) * 2048 + head * 512;
    u16* Kc = (u16*)smem;
    u16* Qc = (u16*)(smem + 36864);
    float* mxs = (float*)(smem + 46080);
    float* sms = mxs + 256;
    u16* Pq = (u16*)smem;
    const u16* kgp = Kg + (size_t)(tid >> 3) * 2048 + (tid & 7) * 8;
    const u16* qgp = Qg + (size_t)(tid >> 3) * 2048 + (tid & 7) * 8;
    u32x4 kr[8], qr[2];
    f32x16 s[2][2];
#pragma unroll
    for (int a = 0; a < 2; ++a)
#pragma unroll
        for (int c = 0; c < 2; ++c) s[a][c] = zero16();
#define XLOAD(dc_) do { _Pragma("unroll") for (int i = 0; i < 8; ++i) kr[i] = *(const u32x4*)(kgp + (size_t)(i * 32) * 2048 + (dc_) * 64); \
        qr[0] = *(const u32x4*)(qgp + (dc_) * 64); qr[1] = *(const u32x4*)(qgp + (size_t)32 * 2048 + (dc_) * 64); } while (0)
#define XSTORE() do { _Pragma("unroll") for (int i = 0; i < 8; ++i) *(u32x4*)&Kc[((tid >> 3) + i * 32) * 72 + (tid & 7) * 8] = kr[i]; \
        *(u32x4*)&Qc[(tid >> 3) * 72 + (tid & 7) * 8] = qr[0]; *(u32x4*)&Qc[((tid >> 3) + 32) * 72 + (tid & 7) * 8] = qr[1]; } while (0)
    XLOAD(0);
    __syncthreads();
    XSTORE();
    __syncthreads();
#pragma unroll 1
    for (int dc = 0; dc < 8; ++dc) {
        if (dc + 1 < 8) XLOAD(dc + 1);
#pragma unroll
        for (int ks = 0; ks < 4; ++ks) {
            bf16x8 kf0 = *(const bf16x8*)&Kc[(w * 64 + r) * 72 + ks * 16 + h * 8];
            bf16x8 kf1 = *(const bf16x8*)&Kc[(w * 64 + 32 + r) * 72 + ks * 16 + h * 8];
            bf16x8 qf0 = *(const bf16x8*)&Qc[r * 72 + ks * 16 + h * 8];
            bf16x8 qf1 = *(const bf16x8*)&Qc[(32 + r) * 72 + ks * 16 + h * 8];
            s[0][0] = MFMA(kf0, qf0, s[0][0]); s[0][1] = MFMA(kf0, qf1, s[0][1]);
            s[1][0] = MFMA(kf1, qf0, s[1][0]); s[1][1] = MFMA(kf1, qf1, s[1][1]);
        }
        __syncthreads();
        if (dc + 1 < 8) { XSTORE(); __syncthreads(); }
    }
#undef XLOAD
#undef XSTORE
#pragma unroll
    for (int qg = 0; qg < 2; ++qg) {
        float mx = NEG;
#pragma unroll
        for (int kb = 0; kb < 2; ++kb)
#pragma unroll
            for (int i = 0; i < 16; ++i) { s[kb][qg][i] *= SC512; mx = fmaxf(mx, s[kb][qg][i]); }
        mx = fmaxf(mx, __shfl_xor(mx, 32));
        if (h == 0) mxs[w * 64 + qg * 32 + r] = mx;
    }
    __syncthreads();
    float linv[2];
#pragma unroll
    for (int qg = 0; qg < 2; ++qg) {
        const int q = qg * 32 + r;
        const float gm = fmaxf(fmaxf(mxs[q], mxs[64 + q]), fmaxf(mxs[128 + q], mxs[192 + q]));
        float sum = 0.f;
#pragma unroll
        for (int kb = 0; kb < 2; ++kb) {
#pragma unroll
            for (int i = 0; i < 16; ++i) { float e = __expf(s[kb][qg][i] - gm); s[kb][qg][i] = e; sum += e; }
#pragma unroll
            for (int a = 0; a < 4; ++a) {
                u32x2 v; v[0] = pk2(s[kb][qg][4 * a], s[kb][qg][4 * a + 1]); v[1] = pk2(s[kb][qg][4 * a + 2], s[kb][qg][4 * a + 3]);
                *(u32x2*)&Pq[q * 264 + w * 64 + kb * 32 + 8 * a + 4 * h] = v;
            }
        }
        sum += __shfl_xor(sum, 32);
        if (h == 0) sms[w * 64 + q] = sum;
    }
    __syncthreads();
#pragma unroll
    for (int qg = 0; qg < 2; ++qg) { const int q = qg * 32 + r; linv[qg] = 1.f / (sms[q] + sms[64 + q] + sms[128 + q] + sms[192 + q]); }
    const u16* VT = (const u16*)(ws + WS_XVT) + (size_t)((b * 4 + head) * 512 + w * 128) * 256;
    f32x16 o[4][2];
#pragma unroll
    for (int db = 0; db < 4; ++db) { o[db][0] = zero16(); o[db][1] = zero16(); }
#pragma unroll 4
    for (int kk = 0; kk < 16; ++kk) {
        bf16x8 pf0 = *(const bf16x8*)&Pq[r * 264 + kk * 16 + h * 8];
        bf16x8 pf1 = *(const bf16x8*)&Pq[(32 + r) * 264 + kk * 16 + h * 8];
#pragma unroll
        for (int db = 0; db < 4; ++db) {
            bf16x8 vf = ldfrag(VT + (size_t)(db * 32 + r) * 256 + kk * 16 + h * 8);
            o[db][0] = MFMA(vf, pf0, o[db][0]);
            o[db][1] = MFMA(vf, pf1, o[db][1]);
        }
    }
#pragma unroll
    for (int qg = 0; qg < 2; ++qg) {
        u16* xo = (u16*)(ws + WS_XO) + (t0 + qg * 32 + r) * 2048 + head * 512 + w * 128;
#pragma unroll
        for (int db = 0; db < 4; ++db)
#pragma unroll
            for (int a = 0; a < 4; ++a) {
                const int d = db * 32 + 8 * a + 4 * h;
                u32x2 ov; ov[0] = pk2(o[db][qg][4 * a] * linv[qg], o[db][qg][4 * a + 1] * linv[qg]); ov[1] = pk2(o[db][qg][4 * a + 2] * linv[qg], o[db][qg][4 * a + 3] * linv[qg]);
                *(u32x2*)&xo[d] = ov;
            }
    }
}

template <int NC, int NJ>
DI void ln_row_store(float (&y)[NC][NJ], const float* gam, const float* bet, float* dstf, u16* dstb, int lane) {
    float sm = 0.f;
#pragma unroll
    for (int c = 0; c < NC; ++c)
#pragma unroll
        for (int j = 0; j < NJ; ++j) sm += y[c][j];
    const float mu = wave_sum(sm) * (1.f / 2048.f);
    float vs = 0.f;
#pragma unroll
    for (int c = 0; c < NC; ++c)
#pragma unroll
        for (int j = 0; j < NJ; ++j) { float d = y[c][j] - mu; vs += d * d; }
    const float rs = rsqrtf(wave_sum(vs) * (1.f / 2048.f) + 1e-5f);
#pragma unroll
    for (int c = 0; c < NC; ++c)
#pragma unroll
        for (int j8 = 0; j8 < NJ; j8 += 8) {
            const int col = (c * 64 + lane) * NJ + j8;
            float4 g0 = *(const float4*)&gam[col], g1 = *(const float4*)&gam[col + 4];
            float4 b0 = *(const float4*)&bet[col], b1 = *(const float4*)&bet[col + 4];
            float4 o0, o1;
            o0.x = (y[c][j8 + 0] - mu) * rs * g0.x + b0.x; o0.y = (y[c][j8 + 1] - mu) * rs * g0.y + b0.y;
            o0.z = (y[c][j8 + 2] - mu) * rs * g0.z + b0.z; o0.w = (y[c][j8 + 3] - mu) * rs * g0.w + b0.w;
            o1.x = (y[c][j8 + 4] - mu) * rs * g1.x + b1.x; o1.y = (y[c][j8 + 5] - mu) * rs * g1.y + b1.y;
            o1.z = (y[c][j8 + 6] - mu) * rs * g1.z + b1.z; o1.w = (y[c][j8 + 7] - mu) * rs * g1.w + b1.w;
            *(float4*)&dstf[col] = o0; *(float4*)&dstf[col + 4] = o1;
            u32x4 pb = {pk2(o0.x, o0.y), pk2(o0.z, o0.w), pk2(o1.x, o1.y), pk2(o1.z, o1.w)};
            *(u32x4*)&dstb[col] = pb;
        }
}

DI void ln_phase(const P& p, const float* gam, const float* bet) {
    size_t wsoff_ = 0; asm volatile("" : "+s"(wsoff_)); char* ws = p.ws + wsoff_;
    const int lane = TID() & 63, w = TID() >> 6;
    const float* y = (const float*)(ws + WS_Y);
    float* xf = (float*)(ws + WS_XF); u16* xb = (u16*)(ws + WS_XB);
    for (int t = BID() * 4 + w; t < T; t += GDIM() * 4) {
        float v[4][8];
#pragma unroll
        for (int c = 0; c < 4; ++c) {
            const int col = (c * 64 + lane) * 8;
            float4 a = *(const float4*)&y[(size_t)t * 2048 + col], bq = *(const float4*)&y[(size_t)t * 2048 + col + 4];
            v[c][0] = a.x; v[c][1] = a.y; v[c][2] = a.z; v[c][3] = a.w; v[c][4] = bq.x; v[c][5] = bq.y; v[c][6] = bq.z; v[c][7] = bq.w;
        }
        ln_row_store(v, gam, bet, xf + (size_t)t * 2048, xb + (size_t)t * 2048, lane);
    }
}

DI unsigned fkey(float x) { unsigned u = __float_as_uint(x); return u ^ ((unsigned)((int)u >> 31) | 0x80000000u); }
DI int mbcnt64(unsigned long long m) { return __builtin_amdgcn_mbcnt_hi((unsigned)(m >> 32), __builtin_amdgcn_mbcnt_lo((unsigned)m, 0u)); }
DI float fkeyinv(unsigned k) { return __uint_as_float((k & 0x80000000u) ? (k ^ 0x80000000u) : ~k); }
template <bool TWO>
DI void wave_top16(unsigned k0, unsigned k1, unsigned pay0, unsigned pay1, int lane, unsigned* kk, unsigned* ki, unsigned* kp, int& rank, unsigned& okey, unsigned& opay) {
    unsigned T = 0u; int cntT = 1000;
#pragma unroll 1
    for (int bit = 31; bit >= 0; --bit) {
        const unsigned c = T | (1u << bit);
        int cnt = __builtin_popcountll(__builtin_amdgcn_ballot_w64(k0 >= c));
        if (TWO) cnt += __builtin_popcountll(__builtin_amdgcn_ballot_w64(k1 >= c));
        if (cnt >= 16) { T = c; cntT = cnt; if (cnt == 16) break; }
    }
    bool sel0, sel1;
    if (cntT == 16) { sel0 = k0 >= T; sel1 = TWO && (k1 >= T); }
    else {
        const bool gt0 = k0 > T, eq0 = k0 == T, gt1 = TWO && (k1 > T), eq1 = TWO && (k1 == T);
        const unsigned long long bg0 = __builtin_amdgcn_ballot_w64(gt0), bg1 = __builtin_amdgcn_ballot_w64(gt1);
        const unsigned long long be0 = __builtin_amdgcn_ballot_w64(eq0), be1 = __builtin_amdgcn_ballot_w64(eq1);
        const int need = 16 - (__builtin_popcountll(bg0) + __builtin_popcountll(bg1));
        sel0 = gt0 || (eq0 && mbcnt64(be0) < need);
        sel1 = gt1 || (eq1 && (__builtin_popcountll(be0) + mbcnt64(be1)) < need);
    }
    const unsigned long long bs0 = __builtin_amdgcn_ballot_w64(sel0), bs1 = __builtin_amdgcn_ballot_w64(sel1);
    CBAR();
    if (sel0) { const int sl = mbcnt64(bs0); kk[sl] = k0; ki[sl] = (unsigned)lane; kp[sl] = pay0; }
    if (sel1) { const int sl = __builtin_popcountll(bs0) + mbcnt64(bs1); kk[sl] = k1; ki[sl] = (unsigned)(lane + 64); kp[sl] = pay1; }
    CBAR();
    const int me = lane & 15;
    const unsigned myk = kk[me], myi = ki[me];
    opay = kp[me]; okey = myk;
    int c = 0;
#pragma unroll
    for (int j = 0; j < 16; j += 4) {
        const u32x4 a = *(const u32x4*)&kk[j]; const u32x4 bq = *(const u32x4*)&ki[j];
#pragma unroll
        for (int q = 0; q < 4; ++q) c += (a[q] > myk) || (a[q] == myk && bq[q] < myi);
    }
    CBAR();
    rank = c;
}

DI void peer_phase(const P& p, int L, char* smem, float* outp) {
    size_t wsoff_ = 0; asm volatile("" : "+s"(wsoff_)); char* ws = p.ws + wsoff_;
    const int lane = TID() & 63, w = TID() >> 6;
    char* wl = smem + w * 4096;
    float* sc = (float*)wl;
    float* s1s = sc + 128; int* i1s = (int*)(s1s + 16); float* s2s = (float*)(i1s + 16); int* i2s = (int*)(s2s + 16);
    float* cv = (float*)(i2s + 16);
    int* cp = (int*)(cv + 64);
    float* tv = (float*)(cp + 64);
    int* te = (int*)(tv + 16);
    int* exl = te + 16;
    float* gx = (float*)(exl + 128);
    const float* scores = (const float*)(ws + WS_SCORES);
    float* xf = (float*)(ws + WS_XF); u16* xb = (u16*)(ws + WS_XB);
    const unsigned char* ub = (const unsigned char*)(ws + WS_UB) + (size_t)L * 16384 * 1536;
    const unsigned char* vb = (const unsigned char*)(ws + WS_VB) + (size_t)L * 16384 * 1536;
    const float* gam = lnd(p.in[I_LN3G]) + L * 2048; const float* bet = lnd(p.in[I_LN3B]) + L * 2048;
    const int lane0 = lane;
    for (int t = BID() * 4 + w; t < T; t += GDIM() * 4) {
        int lane = lane0; asm volatile("" : "+v"(lane));
        int ca = 0, cb = lane;
        { int a = 0, rem = lane; for (; a < 16; ++a) { int cnt = 16 / (a + 1); if (rem < cnt) break; rem -= cnt; } ca = a; cb = rem; }
        const bool cvalid = ca < 16;
        const float* srow = scores + (size_t)t * 2048 + lane;
        float n00 = srow[0], n01 = srow[64], n10 = srow[128], n11 = srow[192];
        for (int hd2 = 0; hd2 < 8 * TOPK_REP; ++hd2) { const int hd = hd2 & 7;
            const float c00 = n00, c01 = n01, c10 = n10, c11 = n11;
            { const int hn = ((hd2 + 1) & 7) * 256; n00 = srow[hn]; n01 = srow[hn + 64]; n10 = srow[hn + 128]; n11 = srow[hn + 192]; }
            for (int p2 = 0; p2 < 2; ++p2) {
                const float v0 = p2 ? c10 : c00, v1 = p2 ? c11 : c01;
                int rk; unsigned ok, op;
                wave_top16<true>(fkey(v0), fkey(v1), (unsigned)lane, (unsigned)(lane + 64), lane, (unsigned*)cv, (unsigned*)cp, (unsigned*)cv + 16, rk, ok, op);
                float* ss = p2 ? s2s : s1s; int* is = p2 ? i2s : i1s;
                if (lane < 16) { ss[rk] = fkeyinv(ok); is[rk] = (int)op; }
                CBAR();
            }
            float val = 0.f; int eid = 0; unsigned ckey = 0u;
            if (cvalid) { val = s1s[ca] + s2s[cb]; eid = i1s[ca] * 128 + i2s[cb]; ckey = fkey(val); }
            CBAR();
            {
                int rk; unsigned ok, op;
                wave_top16<false>(ckey, 0u, (unsigned)eid, 0u, lane, (unsigned*)cv, (unsigned*)cp, (unsigned*)cv + 16, rk, ok, op);
                if (lane < 16) { tv[rk] = fkeyinv(ok); te[rk] = (int)op; }
            }
            CBAR();
            {
                const int li = lane & 15;
                const float tmax = tv[0];
                float e = __expf(tv[li] - tmax);
                float sum = e;
                sum += __shfl_xor(sum, 1); sum += __shfl_xor(sum, 2); sum += __shfl_xor(sum, 4); sum += __shfl_xor(sum, 8);
                if (lane < 16) { gx[hd * 16 + lane] = e / sum; exl[hd * 16 + lane] = te[lane]; }
            }
            CBAR();
        }
        asm volatile("" : "+v"(lane));
        float x[1][32], acc[1][32];
        const float* xr = xf + (size_t)t * 2048 + lane * 32;
#pragma unroll
        for (int q = 0; q < 8; ++q) {
            float4 a = *(const float4*)&xr[4 * q];
            x[0][4 * q] = a.x; x[0][4 * q + 1] = a.y; x[0][4 * q + 2] = a.z; x[0][4 * q + 3] = a.w;
        }
#pragma unroll
        for (int j = 0; j < 32; ++j) acc[0][j] = 0.f;
        const unsigned voff24 = (unsigned)lane * 24u;
#pragma unroll 1
        for (int k = 0; k < 128; k += 4) {
            int e[4]; float gq[4];
#pragma unroll
            for (int q = 0; q < 4; ++q) { e[q] = __builtin_amdgcn_readfirstlane(exl[k + q]); gq[q] = gx[k + q]; }
            u32x6 ua[4], va[4];
#pragma unroll
            for (int q = 0; q < 4; ++q) {
                const u32x2* sp = (const u32x2*)((ub + (size_t)e[q] * 1536) + (size_t)voff24);
                const u32x2 a0 = sp[0], a1 = sp[1], a2 = sp[2];
                ua[q][0] = a0[0]; ua[q][1] = a0[1]; ua[q][2] = a1[0]; ua[q][3] = a1[1]; ua[q][4] = a2[0]; ua[q][5] = a2[1];
            }
#pragma unroll
            for (int q = 0; q < 4; ++q) {
                const u32x2* sp = (const u32x2*)((vb + (size_t)e[q] * 1536) + (size_t)voff24);
                const u32x2 a0 = sp[0], a1 = sp[1], a2 = sp[2];
                va[q][0] = a0[0]; va[q][1] = a0[1]; va[q][2] = a1[0]; va[q][3] = a1[1]; va[q][4] = a2[0]; va[q][5] = a2[1];
            }
            float d[4];
#pragma unroll
            for (int q = 0; q < 4; ++q) {
                const f32x32 uu = __builtin_amdgcn_cvt_scalef32_pk32_f32_fp6(ua[q], 1.0f);
                float dd = 0.f;
#pragma unroll
                for (int j = 0; j < 32; ++j) dd += x[0][j] * uu[j];
                d[q] = dd;
                if (q < 3) { unsigned t0 = ua[q + 1][0]; asm volatile("" : "+v"(t0) : "v"(dd)); ua[q + 1][0] = t0; }
            }
            float f[4];
            {
                const bool b5 = (lane & 32) != 0, b4 = (lane & 16) != 0;
                float a = b5 ? d[1] : d[0], bb = b5 ? d[0] : d[1];
                float c = b5 ? d[3] : d[2], e = b5 ? d[2] : d[3];
                a += __shfl_xor(bb, 32); c += __shfl_xor(e, 32);
                float xx = b4 ? c : a, yy = b4 ? a : c;
                xx += __shfl_xor(yy, 16);
                xx += __shfl_xor(xx, 8); xx += __shfl_xor(xx, 4); xx += __shfl_xor(xx, 2); xx += __shfl_xor(xx, 1);
                const float gsel = b5 ? (b4 ? gq[3] : gq[1]) : (b4 ? gq[2] : gq[0]);
                const float fsel = gsel * gelu_erf(xx * (1.f / 64.f)) * (1.f / 8.f);
                f[0] = __int_as_float(__builtin_amdgcn_readlane(__float_as_int(fsel), 0));
                f[1] = __int_as_float(__builtin_amdgcn_readlane(__float_as_int(fsel), 32));
                f[2] = __int_as_float(__builtin_amdgcn_readlane(__float_as_int(fsel), 16));
                f[3] = __int_as_float(__builtin_amdgcn_readlane(__float_as_int(fsel), 48));
            }
#pragma unroll
            for (int q = 0; q < 4; ++q) {
                const f32x32 vv = __builtin_amdgcn_cvt_scalef32_pk32_f32_fp6(va[q], 1.0f);
#pragma unroll
                for (int j = 0; j < 32; ++j) acc[0][j] += f[q] * vv[j];
                if (q < 3) { unsigned t0 = va[q + 1][0]; asm volatile("" : "+v"(t0) : "v"(acc[0][0])); va[q + 1][0] = t0; }
            }
        }
#pragma unroll
        for (int j = 0; j < 32; ++j) acc[0][j] += ALPHA * x[0][j];
        ln_row_store<1, 32>(acc, gam, bet, outp + (size_t)t * 2048, xb + (size_t)t * 2048, lane);
    }
}

DI void prep_phase(const P& p, char* smem) {
    size_t wsoff_ = 0; asm volatile("" : "+s"(wsoff_)); char* ws = p.ws + wsoff_;
    const size_t gtid = (size_t)BID() * 256 + TID(), gsz = (size_t)GDIM() * 256;
    {
        const float* x = lnd(p.in[I_X]); u16* xb = (u16*)(ws + WS_XB);
        for (size_t i = gtid; i < (size_t)T * 2048 / 8; i += gsz) {
            float4 a = *(const float4*)&x[i * 8], b = *(const float4*)&x[i * 8 + 4];
            u32x4 o = {pk2(a.x, a.y), pk2(a.z, a.w), pk2(b.x, b.y), pk2(b.z, b.w)};
            *(u32x4*)&xb[i * 8] = o;
        }
        const float* mm = lnd(p.in[I_MEM]); u16* mb = (u16*)(ws + WS_MEMB);
        for (size_t i = gtid; i < (size_t)1024 * 2048 / 8; i += gsz) {
            float4 a = *(const float4*)&mm[i * 8], b = *(const float4*)&mm[i * 8 + 4];
            u32x4 o = {pk2(a.x, a.y), pk2(a.z, a.w), pk2(b.x, b.y), pk2(b.z, b.w)};
            *(u32x4*)&mb[i * 8] = o;
        }
    }
    {
        int* sigs = (int*)(smem + 36864);
        __syncthreads();
        {
            f32x16v pa, pbv, qa, qb;
#pragma unroll
            for (int i = 0; i < 16; ++i) { pa[i] = (float)(i & 7); pbv[i] = (float)((16 + i) & 7); qa[i] = (float)(i >> 3); qb[i] = (float)((16 + i) >> 3); }
            const u32x6 e1 = __builtin_amdgcn_cvt_scalef32_2xpk16_fp6_f32(pa, pbv, 1.0f);
            const u32x6 e2 = __builtin_amdgcn_cvt_scalef32_2xpk16_fp6_f32(qa, qb, 1.0f);
            const f32x32 d1 = __builtin_amdgcn_cvt_scalef32_pk32_f32_fp6(e1, 1.0f);
            const f32x32 d2 = __builtin_amdgcn_cvt_scalef32_pk32_f32_fp6(e2, 1.0f);
            if (TID() == 0) {
#pragma unroll
                for (int j = 0; j < 32; ++j) { const int slot = ((int)(d1[j] + 0.5f) + 8 * (int)(d2[j] + 0.5f)) & 31; sigs[slot] = j; }
            }
        }
        __syncthreads();
        __builtin_amdgcn_sched_barrier(0);
        { int lz = 0; asm volatile("" : "+v"(lz)); sigs += lz; }
        const float* u = lnd(p.in[I_PU]); const float* v = lnd(p.in[I_PV]);
        unsigned char* ub = (unsigned char*)(ws + WS_UB); unsigned char* vb = (unsigned char*)(ws + WS_VB);
        const size_t n32 = (size_t)2 * 16384 * 2048 / 32;
        const int lane_ = TID() & 63, w_ = TID() >> 6;
        float* wreg = (float*)(smem + w_ * 8448);
        for (size_t i = gtid; i < n32; i += gsz) {
            const size_t wbase = (i - (size_t)lane_) * 32;
#pragma unroll 1
            for (int tb = 0; tb < 2; ++tb) {
                const float* src = (tb ? v : u) + wbase;
                const float scl = tb ? 8.f : 64.f;
                CBAR();
#pragma unroll
                for (int k = 0; k < 8; ++k) {
                    const float4 v4 = *(const float4*)(src + (size_t)(k * 64 + lane_) * 4);
                    float* d = wreg + (k * 8 + (lane_ >> 3)) * 33 + (lane_ & 7) * 4;
                    d[0] = v4.x; d[1] = v4.y; d[2] = v4.z; d[3] = v4.w;
                }
                CBAR();
                const float* mine = wreg + lane_ * 33;
                f32x16v xa, xb2;
#pragma unroll
                for (int q = 0; q < 16; q += 4) {
                    const int4 s0 = *(const int4*)&sigs[q], s1 = *(const int4*)&sigs[16 + q];
                    xa[q] = mine[s0.x] * scl; xa[q + 1] = mine[s0.y] * scl; xa[q + 2] = mine[s0.z] * scl; xa[q + 3] = mine[s0.w] * scl;
                    xb2[q] = mine[s1.x] * scl; xb2[q + 1] = mine[s1.y] * scl; xb2[q + 2] = mine[s1.z] * scl; xb2[q + 3] = mine[s1.w] * scl;
                }
                CBAR();
                const u32x6 o = __builtin_amdgcn_cvt_scalef32_2xpk16_fp6_f32(xa, xb2, 1.0f);
                u32x2 o0 = {o[0], o[1]}, o1 = {o[2], o[3]}, o2 = {o[4], o[5]};
                u32x2* dst = (u32x2*)((tb ? vb : ub) + i * 24); dst[0] = o0; dst[1] = o1; dst[2] = o2;
            }
        }
    }
    {
        float2* tab = (float2*)(ws + WS_ROPE);
        for (size_t i = gtid; i < (size_t)2048 * 64; i += gsz) {
            const int s = (int)(i >> 6), j = (int)(i & 63);
            const float inv = 1.0f / powf(10000.f, (float)(2 * j) / 128.f);
            const float ang = (float)s * inv;
            tab[i] = make_float2(cosf(ang), sinf(ang));
        }
    }
    {
        float* tl = (float*)smem;
        const int tid = TID();
        const int per_layer = 32 * 105 + 5 * 1024 + 256;
        const int n4 = (tid & 15) * 4, kr = tid >> 4;
        const float* src = nullptr; u16* dst = nullptr; int N = 0, Kd = 0, kt = 0, nt = 0;
        const float* nsrc = nullptr; u16* ndst = nullptr; int nN = 0, nKd = 0, nkt = 0, nnt = 0;
        float4 v0, v1, v2, v3;
#define TRDESC(it_, SRC, DST, NN, KD, KT, NT) do { const int L_ = (it_) / per_layer; int q_ = (it_) - L_ * per_layer; \
            u16* wl_ = (u16*)(ws + WS_WT) + (size_t)L_ * WT_LAYER; \
            if (q_ < 32 * 105) { SRC = lnd(p.in[I_WIN]) + (size_t)L_ * 2048 * PIN; DST = wl_ + WT_IN; NN = PIN; KD = 2048; KT = q_ / 105; NT = q_ - KT * 105; } \
            else if (q_ < 32 * 105 + 5 * 1024) { \
                q_ -= 32 * 105; const int m_ = q_ >> 10; q_ &= 1023; KT = q_ >> 5; NT = q_ & 31; NN = 2048; KD = 2048; \
                const int idx_ = (m_ == 0) ? I_WOUT : (m_ == 1) ? I_XWQ : (m_ == 2) ? I_XWK : (m_ == 3) ? I_XWV : I_XWO; \
                SRC = lnd(p.in[idx_]) + (size_t)L_ * 2048 * 2048; DST = wl_ + WT_OUT + (size_t)m_ * 2048 * 2048; \
            } else { \
                q_ -= 32 * 105 + 5 * 1024; const int i_ = q_ >> 7; q_ &= 127; KT = q_ >> 1; NT = q_ & 1; NN = 128; KD = 4096; \
                SRC = lnd(p.in[I_CW1]) + (size_t)(L_ * 2 + i_) * 4096 * 128; DST = wl_ + WT_CW1 + (size_t)i_ * 128 * 4096; \
            } } while (0)
#define TRLOAD(SRC, NN, KT, NT) do { const int n_ = (NT) * 64 + n4; const float4 z_ = make_float4(0.f, 0.f, 0.f, 0.f); v0 = z_; v1 = z_; v2 = z_; v3 = z_; \
            if (n_ < (NN)) { const float* b_ = (SRC) + (size_t)((KT) * 64 + kr) * (NN) + n_; \
                v0 = *(const float4*)(b_); v1 = *(const float4*)(b_ + (size_t)16 * (NN)); v2 = *(const float4*)(b_ + (size_t)32 * (NN)); v3 = *(const float4*)(b_ + (size_t)48 * (NN)); } } while (0)
        const int total = 2 * per_layer;
        int it = BID();
        if (it < total) { TRDESC(it, src, dst, N, Kd, kt, nt); TRLOAD(src, N, kt, nt); }
        for (; it < total; it += GDIM()) {
            const bool hn = it + GDIM() < total;
            __syncthreads();
            {
                float* t0 = tl + kr * 65 + n4;
                t0[0] = v0.x; t0[1] = v0.y; t0[2] = v0.z; t0[3] = v0.w;
                t0[16 * 65 + 0] = v1.x; t0[16 * 65 + 1] = v1.y; t0[16 * 65 + 2] = v1.z; t0[16 * 65 + 3] = v1.w;
                t0[32 * 65 + 0] = v2.x; t0[32 * 65 + 1] = v2.y; t0[32 * 65 + 2] = v2.z; t0[32 * 65 + 3] = v2.w;
                t0[48 * 65 + 0] = v3.x; t0[48 * 65 + 1] = v3.y; t0[48 * 65 + 2] = v3.z; t0[48 * 65 + 3] = v3.w;
            }
            if (hn) { TRDESC(it + GDIM(), nsrc, ndst, nN, nKd, nkt, nnt); TRLOAD(nsrc, nN, nkt, nnt); }
            __syncthreads();
#pragma unroll
            for (int i2 = 0; i2 < 2; ++i2) {
                const int c = tid + 256 * i2, n = c >> 3, kc = c & 7;
                if (nt * 64 + n < N) {
                    const float* tp = tl + (kc * 8) * 65 + n;
                    u32x4 o = {pk2(tp[0], tp[65]), pk2(tp[130], tp[195]), pk2(tp[260], tp[325]), pk2(tp[390], tp[455])};
                    *(u32x4*)&dst[(size_t)(nt * 64 + n) * Kd + kt * 64 + kc * 8] = o;
                }
            }
            src = nsrc; dst = ndst; N = nN; Kd = nKd; kt = nkt; nt = nnt;
        }
#undef TRDESC
#undef TRLOAD
    }
    {
        float* pb = (float*)(ws + WS_POSB);
        for (int it = BID(); it < 2 * 2 * 32; it += GDIM()) {
            const int part = it & 31, li = it >> 5;
            const int col = TID() & 127, half = TID() >> 7;
            const float* pos = lnd(p.in[I_CPOS]) + (size_t)li * 4096;
            const float* w1 = lnd(p.in[I_CW1]) + (size_t)li * 4096 * 128;
            const int r0 = part * 128 + half * 64;
            float s = 0.f;
            for (int q = 0; q < 64; ++q) s += pos[r0 + q] * w1[(size_t)(r0 + q) * 128 + col];
            pb[((size_t)li * 64 + part * 2 + half) * 128 + col] = s;
        }
    }
    {
        const int lane = TID() & 63, w = TID() >> 6, r = lane & 31, h = lane >> 5;
        for (int it = BID(); it < 2 * 16 * 16; it += GDIM()) {
            const int dblk = it & 15, hp = (it >> 4) & 15, L = it >> 8;
            const float* wq = lnd(p.in[I_PWQ]) + (size_t)L * 2048 * 2048;
            const float* sk = lnd(p.in[I_PSK]) + ((size_t)L * 16 + hp) * 128 * 128;
            u16* wpt = (u16*)(ws + WS_WT) + (size_t)L * WT_LAYER + WT_WP;
            const int d = dblk * 128 + w * 32 + r;
            f32x16 acc[4];
#pragma unroll
            for (int nb = 0; nb < 4; ++nb) acc[nb] = zero16();
#pragma unroll 1
            for (int ks = 0; ks < 8; ++ks) {
                const float* apx = wq + (size_t)d * 2048 + hp * 128 + ks * 16 + h * 8;
                float4 a0 = *(const float4*)apx, a1 = *(const float4*)(apx + 4);
                float av[8] = {a0.x, a0.y, a0.z, a0.w, a1.x, a1.y, a1.z, a1.w};
                float ahf[8], alf[8];
#pragma unroll
                for (int q = 0; q < 8; ++q) { ahf[q] = __uint_as_float((unsigned)f2bf(av[q]) << 16); alf[q] = av[q] - ahf[q]; }
                bf16x8 ah = pack8(ahf[0], ahf[1], ahf[2], ahf[3], ahf[4], ahf[5], ahf[6], ahf[7]);
                bf16x8 al = pack8(alf[0], alf[1], alf[2], alf[3], alf[4], alf[5], alf[6], alf[7]);
#pragma unroll
                for (int nb = 0; nb < 4; ++nb) {
                    const float* bpx = sk + (size_t)(nb * 32 + r) * 128 + ks * 16 + h * 8;
                    float4 b0 = *(const float4*)bpx, b1 = *(const float4*)(bpx + 4);
                    float bv[8] = {b0.x, b0.y, b0.z, b0.w, b1.x, b1.y, b1.z, b1.w};
                    float bhf[8], blf[8];
#pragma unroll
                    for (int q = 0; q < 8; ++q) { bhf[q] = __uint_as_float((unsigned)f2bf(bv[q]) << 16); blf[q] = bv[q] - bhf[q]; }
                    bf16x8 bh = pack8(bhf[0], bhf[1], bhf[2], bhf[3], bhf[4], bhf[5], bhf[6], bhf[7]);
                    bf16x8 bl = pack8(blf[0], blf[1], blf[2], blf[3], blf[4], blf[5], blf[6], blf[7]);
                    acc[nb] = MFMA(ah, bh, acc[nb]);
                    acc[nb] = MFMA(ah, bl, acc[nb]);
                    acc[nb] = MFMA(al, bh, acc[nb]);
                }
            }
#pragma unroll
            for (int nb = 0; nb < 4; ++nb)
#pragma unroll
                for (int a = 0; a < 4; ++a) {
                    u32x2 v; v[0] = pk2(acc[nb][4 * a], acc[nb][4 * a + 1]); v[1] = pk2(acc[nb][4 * a + 2], acc[nb][4 * a + 3]);
                    *(u32x2*)&wpt[(size_t)(hp * 128 + nb * 32 + r) * 2048 + dblk * 128 + w * 32 + 8 * a + 4 * h] = v;
                }
        }
    }
}

#define XB_TMO      128
#define XB_XCNT(j)  (256  + 64 * (j))
#define XB_XSUB(j)  (1280 + 64 * (j))
#define XB_XGEN(j)  (2304 + 64 * (j))
#define XB_TOP      3328
#define XB_TOPGEN   3392
#define XCD_BAR_WORDS 3456
#define XB_SPIN_CAP (1u << 18)
#define LAS __attribute__((address_space(3)))

__device__ __forceinline__ unsigned* xb_va(unsigned* p) { unsigned z = 0; asm volatile("" : "+v"(z)); return (unsigned*)((char*)p + (size_t)z); }
__device__ __forceinline__ unsigned xb_ld(unsigned* p)              { return __hip_atomic_load(xb_va(p), __ATOMIC_RELAXED, __HIP_MEMORY_SCOPE_AGENT); }
__device__ __forceinline__ unsigned xb_add(unsigned* p, unsigned v) { return __hip_atomic_fetch_add(xb_va(p), v, __ATOMIC_RELAXED, __HIP_MEMORY_SCOPE_AGENT); }
__device__ __forceinline__ unsigned xb_xcc_id() { return (unsigned)__builtin_amdgcn_s_getreg((3 << 11) | 20) & 0xFu; }
#define XB_SPIN(cond, bar) do { unsigned _sp = 0; while (cond) { __builtin_amdgcn_s_sleep(1); \
    if ((++_sp & 255u) == 0u) { if (xb_ld(&(bar)[XB_TMO])) break; if (_sp > XB_SPIN_CAP) { atomicAdd(&(bar)[XB_TMO], 1u); break; } } } } while (0)

struct XcdBarrier {
    unsigned* bar; unsigned x;
    volatile LAS unsigned* st;
};

__device__ __forceinline__ XcdBarrier xcd_barrier_post(unsigned* bar, volatile LAS unsigned* st) {
    XcdBarrier b; b.bar = bar; b.x = xb_xcc_id(); b.st = st;
    if (threadIdx.x == 0) (void)xb_add(&bar[XB_XCNT(b.x)], 1u);
    return b;
}
__device__ __forceinline__ void xcd_barrier_complete(unsigned* bar, unsigned x, unsigned& nloc, unsigned& nx) {
    const unsigned G = gridDim.x * gridDim.y * gridDim.z;
    unsigned sum, cnt, mine, sp = 0u;
    for (;;) {
        sum = 0u; cnt = 0u; mine = 0u;
#pragma unroll
        for (unsigned j = 0; j < 16; ++j) { const unsigned c = xb_ld(&bar[XB_XCNT(j)]); sum += c; cnt += (c > 0u) ? 1u : 0u; mine = (j == x) ? c : mine; }
        if (sum == G) break;
        __builtin_amdgcn_s_sleep(1);
        if ((++sp & 255u) == 0u) { if (xb_ld(&bar[XB_TMO])) break; if (sp > XB_SPIN_CAP) { atomicAdd(&bar[XB_TMO], 1u); break; } }
    }
    nloc = mine > 0u ? mine : 1u; nx = cnt > 0u ? cnt : 1u;
}

__device__ __forceinline__ void xcd_barrier(const XcdBarrier& b) {
    asm volatile("s_waitcnt vmcnt(0)" ::: "memory");
    __syncthreads();
    if (threadIdx.x == 0) {
        unsigned* bar = b.bar;
        const unsigned bx = xb_xcc_id();
        __builtin_amdgcn_s_waitcnt(0);
        unsigned nloc = b.st[0], nx = b.st[1];
        if (nloc == 0u) { xcd_barrier_complete(bar, bx, nloc, nx); b.st[0] = nloc; b.st[1] = nx; }
        const unsigned old = xb_add(&bar[XB_XSUB(bx)], 1u);
        const unsigned gen = old / nloc;
        if (old + 1u == (gen + 1u) * nloc) {
            __builtin_amdgcn_fence(__ATOMIC_RELEASE, "agent");
            asm volatile("s_waitcnt vmcnt(0)" ::: "memory");
            const unsigned og = xb_add(&bar[XB_TOP], 1u);
            const unsigned tg = og / nx;
            if (og + 1u == (tg + 1u) * nx) xb_add(&bar[XB_TOPGEN], 1u);
            else XB_SPIN(xb_ld(&bar[XB_TOPGEN]) == tg, bar);
            __builtin_amdgcn_fence(__ATOMIC_ACQUIRE, "agent");
            xb_add(&bar[XB_XGEN(bx)], 1u);
            asm volatile("s_waitcnt vmcnt(0)" ::: "memory");
        } else {
            XB_SPIN(xb_ld(&bar[XB_XGEN(bx)]) == gen, bar);
            __builtin_amdgcn_fence(__ATOMIC_ACQUIRE, "agent");
            asm volatile("s_waitcnt vmcnt(0)" ::: "memory");
        }
    }
    __syncthreads();
}


#ifndef REP_MASK
#define REP_MASK 0
#endif
#ifndef TOPK_REP
#define TOPK_REP 1
#endif
enum { K_GEMM = 0, K_ATTN0, K_ATTN1, K_RETSTATE, K_CMP, K_RETOUT, K_XATTN, K_CMPFIN, K_RETSCAN };

DI void make_desc(const P& p, int L, int ph, int it, const float* xres, GT& g) {
    size_t wsoff_ = 0; asm volatile("" : "+s"(wsoff_)); char* ws = p.ws + wsoff_;
    g.aux = nullptr; g.dst = nullptr; g.amode = 0; g.kbeg = 0; g.ncols = 128; g.e0 = 0; g.e1 = 0;
    if (ph == 0) {
        if (it < 53 * 32) { inproj_desc(p, L, it >> 5, it & 31, g); }
        else {
            int q = it - 53 * 32; int which = q >> 6; int nt = (q >> 2) & 15, mt = q & 3;
            g.A = (const u16*)(ws + WS_MEMB); g.lda = 2048; g.M = 1024; g.m0 = mt * 256; g.ldb = 2048; g.K = 2048;
            g.B = (const u16*)(ws + WS_WT) + (size_t)L * WT_LAYER + (which ? WT_XV : WT_XK) + (size_t)(nt * 128) * 2048;
            if (which == 0) { g.emode = E_PLAIN; g.dst = ws + WS_XK; g.e0 = 2048; g.e1 = nt * 128; }
            else { g.emode = E_XVT; g.dst = ws + WS_XVT; g.e0 = 0; g.e1 = nt * 128; }
        }
    } else if (ph == 1) {
        const int mt = it & 3, ksp = (it >> 2) & 7, i = it >> 5;
        g.A = (const u16*)(ws + (i ? WS_VC : WS_KC)); g.lda = 0; g.amode = 1; g.kbeg = ksp * 512; g.M = 1024; g.m0 = mt * 256;
        g.B = (const u16*)(ws + WS_WT) + (size_t)L * WT_LAYER + WT_CW1 + (size_t)i * 128 * 4096 + ksp * 512; g.ldb = 4096; g.K = 512;
        g.emode = E_F32; g.e0 = 128; g.e1 = 0; g.dst = ws + WS_CPART + (size_t)(i * 8 + ksp) * 1024 * 128 * 4;
    } else {
        const int nt = it >> 5, mt = it & 31;
        g.lda = 2048; g.M = T; g.m0 = mt * 256; g.ldb = 2048; g.K = 2048; g.e1 = nt * 128;
        const u16* wt = (const u16*)(ws + WS_WT) + (size_t)L * WT_LAYER;
        if (ph == 5) { g.A = (const u16*)(ws + WS_MIX); g.B = wt + WT_OUT + (size_t)(nt * 128) * 2048; g.emode = E_RESID; g.aux = xres; }
        else if (ph == 7) { g.A = (const u16*)(ws + WS_XB); g.B = wt + WT_XQ + (size_t)(nt * 128) * 2048; g.emode = E_PLAIN; g.e0 = 2048; g.dst = ws + WS_XQ; }
        else if (ph == 9) { g.A = (const u16*)(ws + WS_XO); g.B = wt + WT_XO + (size_t)(nt * 128) * 2048; g.emode = E_RESID; g.aux = (const float*)(ws + WS_XF); }
        else { g.A = (const u16*)(ws + WS_XB); g.B = wt + WT_WP + (size_t)(nt * 128) * 2048; g.emode = E_F32; g.e0 = 2048; g.dst = ws + WS_SCORES; }
    }
}

__global__ void __launch_bounds__(256, 2) mega(P p) {
    cg::grid_group grid = cg::this_grid();
    __shared__ __attribute__((aligned(16))) char smem[61440];
    size_t wsoff_ = 0; asm volatile("" : "+s"(wsoff_)); char* ws = p.ws + wsoff_;
    const int G = GDIM(), bid = BID();

    __shared__ uint4 xb_words;
    unsigned* barw = (unsigned*)(ws + WS_BAR);
    if (threadIdx.x == 0) xb_words = make_uint4(0u, 0u, 0u, 0u);
    __syncthreads();
    XcdBarrier xb = xcd_barrier_post(barw, (volatile LAS unsigned*)&xb_words);
    if (p.ws == nullptr) grid.sync();
    for (int rep = 0; rep < 1 + ((REP_MASK >> 13) & 1); ++rep) prep_phase(p, smem);
    xcd_barrier(xb);

#pragma unroll 1
    for (int L = 0; L < 2; ++L) {
        const float* xres = (L == 0) ? lnd(p.in[I_X]) : (const float*)(ws + WS_XF);
#pragma unroll 1
        for (int ph = 0; ph < 13; ++ph) {
#pragma unroll 1
            for (int rep = 0; rep < 1 + ((REP_MASK >> ph) & 1); ++rep)
            if (ph == 6 || ph == 10) {
                const int gi = (ph == 6) ? I_LN1G : I_LN2G;
                ln_phase(p, lnd(p.in[gi]) + L * 2048, lnd(p.in[gi + 1]) + L * 2048);
            } else if (ph == 12) {
                peer_phase(p, L, smem, (rep < ((REP_MASK >> 12) & 1)) ? (float*)(ws + WS_Y) : (L == 1) ? p.out : (float*)(ws + WS_XF));
            } else {
                int n = 512;
                if (ph == 0) n = 53 * 32 + 128; else if (ph == 1) n = 64 + 512 + 512; else if (ph == 2) n = 256 + 512; else if (ph == 3) n = 1024;
#pragma unroll 1
                for (int it = bid; it < n; it += G) {
                    int kind = K_GEMM, sub = it;
                    if (ph == 1) { if (it >= 576) { kind = K_RETSTATE; sub = it - 576; } else if (it >= 64) { kind = K_ATTN0; sub = it - 64; } }
                    else if (ph == 2) { if (it < 256) kind = K_CMPFIN; else { kind = K_RETSCAN; sub = it - 256; } }
                    else if (ph == 3) { if (it < 512) kind = K_CMP; else { kind = K_RETOUT; sub = it - 512; } }
                    else if (ph == 4) { kind = K_ATTN1; if (it >= 256) sub = it ^ 63; }
                    else if (ph == 8) kind = K_XATTN;
                    switch (kind) {
                    case K_GEMM: { GT g; make_desc(p, L, ph, sub, xres, g); gemm_tile(p, L, smem, g); } break;
                    case K_ATTN0: attn_item<0>(p, sub, smem); break;
                    case K_ATTN1: attn_item<1>(p, sub, smem); break;
                    case K_RETSTATE: retstate_item(p, sub); break;
                    case K_CMP: cmp_item(p, sub, smem); break;
                    case K_RETOUT: retout_item(p, L, sub, smem); break;
                    case K_XATTN: xattn_item(p, sub, smem); break;
                    case K_CMPFIN: cmpfin_item(p, L, sub, smem); break;
                    case K_RETSCAN: retscan_item(p, sub); break;
                    }
                }
            }
            { size_t bo = 0; asm volatile("" : "+s"(bo)); xb.bar = (unsigned*)(p.ws + bo + WS_BAR); }
            xcd_barrier(xb);
        }
    }
}

extern "C" void kernel_launch(void* const* d_in, const int* in_sizes, int n_in, void* d_out, int out_size, void* d_ws, size_t ws_size,
                              hipStream_t stream) {
    static int grid_blocks = 0;
    if (!grid_blocks) {
        int dev = 0, cus = 0, per_cu = 0;
        (void)hipGetDevice(&dev);
        (void)hipDeviceGetAttribute(&cus, hipDeviceAttributeMultiprocessorCount, dev);
        (void)hipOccupancyMaxActiveBlocksPerMultiprocessor(&per_cu, mega, 256, 0);
        if (per_cu > 2) per_cu = 2;
        if (per_cu < 1) per_cu = 1;
        grid_blocks = cus * per_cu;
        if (ws_size < WS_END) fprintf(stderr, "kernel_launch: workspace too small: %zu < %zu\n", ws_size, (size_t)WS_END);
    }
    P p{};
    for (int i = 0; i < 24; ++i) p.in[i] = (const float*)d_in[i];
    p.out = (float*)d_out;
    p.ws = (char*)d_ws;
    void* args[] = {&p};
    if (hipMemsetAsync((char*)d_ws + WS_BAR, 0, XCD_BAR_WORDS * sizeof(unsigned), stream) != hipSuccess) { fprintf(stderr, "kernel_launch: memset of the barrier words failed\n"); return; }
    hipError_t e = hipLaunchCooperativeKernel((void*)mega, dim3(grid_blocks), dim3(256), args, 0, stream);
    if (e != hipSuccess) fprintf(stderr, "cooperative launch failed: %s (grid %d)\n", hipGetErrorString(e), grid_blocks);
}
```
